# Optimizing an MI355X kernel written in HIP

```python
import math
import jax, jax.numpy as jnp
from jax import lax
import numpy as np

D_MODEL = 1024
BATCH = 16
SEQ = 2048
DEPTH = 1

PLE_DIM = 256
DA_HEADS = 4
DA_QK = 64
DA_V = 2 * DA_QK
DA_WIDTH = DA_HEADS * DA_V
RW_HEADS = 8
RW_N = 64
RW_WIDTH = RW_HEADS * RW_N
DECAY_LORA = 64
AAA_LORA = 64
GATE_LORA = 160
MIX_WIDTH = DA_WIDTH + RW_WIDTH
N_BUCKETS = 32
MAX_DISTANCE = 128
Q_BLOCK = 128
N_EXPERTS = 16
EC_FACTOR = 2
D_FF = 2048
NORM_EPS = 1e-6
RW_LN_EPS = 64e-5

DA_COLS = 3 * DA_WIDTH
RW_SIZES = [RW_WIDTH, RW_WIDTH, RW_WIDTH, 2 * DECAY_LORA, 2 * AAA_LORA, GATE_LORA]
RW_COLS = sum(RW_SIZES)
IN_COLS = DA_COLS + RW_COLS

kernel_name = "hybrid_diffattn_rwkv7_ecmoe_block"


def rmsnorm(x, g, eps=NORM_EPS):
    xf = x.astype(jnp.float32)
    y = xf * lax.rsqrt(jnp.mean(xf * xf, axis=-1, keepdims=True) + eps)
    return (y * g.astype(jnp.float32)).astype(x.dtype)


def t5_bucket(rel):
    half = N_BUCKETS // 2
    max_exact = half // 2
    ret = jnp.where(rel > 0, half, 0)
    n = jnp.abs(rel)
    nf = jnp.maximum(n, 1).astype(jnp.float32)
    large = max_exact + (jnp.log(nf / max_exact) / math.log(MAX_DISTANCE / max_exact)
                         * (half - max_exact)).astype(jnp.int32)
    large = jnp.minimum(large, half - 1)
    return ret + jnp.where(n < max_exact, n, large)


def diff_attention(q, k, v, lam, rel_bias):
    B, S, H, _, dq = q.shape
    dv = v.shape[-1]
    nb = S // Q_BLOCK
    qb = q.reshape(B, nb, Q_BLOCK, H, 2, dq).transpose(1, 0, 3, 4, 2, 5)
    kt = k.transpose(0, 2, 3, 1, 4)
    vt = v.transpose(0, 2, 1, 3)
    kpos = jnp.arange(S, dtype=jnp.int32)
    scale = DA_QK ** -0.5

    def block(args):
        qblk, start = args
        qpos = start + jnp.arange(Q_BLOCK, dtype=jnp.int32)
        bias = rel_bias[t5_bucket(kpos[None, :] - qpos[:, None])]
        bias = bias.astype(jnp.float32).transpose(2, 0, 1)[None, :, None]
        logits = jnp.einsum('bhcqd,bhckd->bhcqk', qblk, kt,
                            preferred_element_type=jnp.float32) * scale + bias
        probs = jax.nn.softmax(logits, axis=-1)
        attn = probs[:, :, 0] - lam * probs[:, :, 1]
        return jnp.einsum('bhqk,bhkd->bhqd', attn.astype(vt.dtype), vt)

    starts = jnp.arange(nb, dtype=jnp.int32) * Q_BLOCK
    out = lax.map(block, (qb, starts))
    return out.transpose(1, 0, 3, 2, 4).reshape(B, S, H, dv)


def diff_attn_mixer(u, q_g, k_g, lq1, lk1, lq2, lk2, subln_g, rel_bias, layer_idx):
    B, S, _ = u.shape
    q, k, v = jnp.split(u, 3, axis=-1)
    q = rmsnorm(q.reshape(B, S, DA_HEADS, 2, DA_QK), q_g)
    k = rmsnorm(k.reshape(B, S, DA_HEADS, 2, DA_QK), k_g)
    v = v.reshape(B, S, DA_HEADS, DA_V)
    lam_init = 0.8 - 0.6 * math.exp(-0.3 * layer_idx)
    lam = (jnp.exp(jnp.sum(lq1.astype(jnp.float32) * lk1.astype(jnp.float32)))
           - jnp.exp(jnp.sum(lq2.astype(jnp.float32) * lk2.astype(jnp.float32))) + lam_init)
    o = diff_attention(q, k, v, lam, rel_bias)
    o = rmsnorm(o, subln_g) * (1.0 - lam_init)
    return o.reshape(B, S, DA_WIDTH)


def centred_shift_mix(u, mu):
    zero = jnp.zeros_like(u[:, :1])
    prev = jnp.concatenate([zero, u[:, :-1]], axis=1)
    nxt = jnp.concatenate([u[:, 1:], zero], axis=1)
    return u + mu * (0.5 * (prev + nxt) - u)


def rwkv7_bidir_scan(r, w, k, v, kk, a):
    _, B, S, H, N = r.shape
    xs = tuple(jnp.moveaxis(t, 2, 0) for t in (r, w, k, v, kk, a))

    def step(state, inp):
        r_t, w_t, k_t, v_t, kk_t, a_t = inp
        sa = jnp.einsum('dbhvk,dbhk->dbhv', state, -kk_t)
        state = (state * w_t[..., None, :] + sa[..., None] * (kk_t * a_t)[..., None, :]
                 + v_t[..., :, None] * k_t[..., None, :])
        y = jnp.einsum('dbhvk,dbhk->dbhv', state, r_t)
        return state, y

    s0 = jnp.zeros((2, B, H, N, N), jnp.float32)
    _, ys = lax.scan(step, s0, xs)
    return jnp.moveaxis(ys, 0, 2)


def rwkv7_mixer(u, mu, w0, w2, a0, a2, g2, k_k, k_a, r_k, lnx_g, lnx_b):
    in_dtype = u.dtype
    u = centred_shift_mix(u.astype(jnp.float32), mu.astype(jnp.float32))
    B, S, _ = u.shape
    offs = list(np.cumsum(RW_SIZES)[:-1])
    r, k, v, wl, al, gl = jnp.split(u, offs, axis=-1)
    f32 = lambda t: t.astype(jnp.float32)
    wl = wl.reshape(B, S, 2, DECAY_LORA)
    al = al.reshape(B, S, 2, AAA_LORA)
    w_logit = f32(w0)[:, None, None, :] + jnp.einsum('bsdr,drc->dbsc', jnp.tanh(wl), f32(w2))
    decay = jnp.exp(-jnp.exp(-jax.nn.softplus(-w_logit) - 0.5))
    a = jax.nn.sigmoid(f32(a0)[:, None, None, :] + jnp.einsum('bsdr,drc->dbsc', al, f32(a2)))
    g = jax.nn.sigmoid(gl) @ f32(g2)
    kk = (k * f32(k_k)).reshape(B, S, RW_HEADS, RW_N)
    kk = kk / jnp.maximum(jnp.sqrt(jnp.sum(kk * kk, axis=-1, keepdims=True)), 1e-12)
    k_dir = k[None] * (1.0 + (a - 1.0) * f32(k_a))
    heads = lambda t: t.reshape(t.shape[:-1] + (RW_HEADS, RW_N))
    rh, vh = heads(r), heads(v)
    kdh, dh, ah = heads(k_dir), heads(decay), heads(a)
    both = lambda t: jnp.stack([t, t[:, ::-1]])
    orient = lambda t: jnp.stack([t[0], t[1][:, ::-1]])
    ys = rwkv7_bidir_scan(both(rh), orient(dh), orient(kdh), both(vh), both(kk), orient(ah))
    y = ys[0] + ys[1][:, ::-1]
    mean = jnp.mean(y, axis=-1, keepdims=True)
    var = jnp.mean(jnp.square(y - mean), axis=-1, keepdims=True)
    y = (y - mean) * lax.rsqrt(var + RW_LN_EPS)
    y = y * heads(f32(lnx_g)) + heads(f32(lnx_b))
    bonus = jnp.sum(rh * (kdh[0] + kdh[1]) * f32(r_k), axis=-1, keepdims=True) * vh
    out = (y + bonus).reshape(B, S, RW_WIDTH) * g
    return out.astype(in_dtype)


def expert_choice_ffn(x, w_router, w1, w3, w2):
    B, S, _ = x.shape
    cap = EC_FACTOR * S // N_EXPERTS
    aff = jax.nn.softmax((x @ w_router).astype(jnp.float32), axis=-1)
    gate, idx = lax.top_k(jnp.swapaxes(aff, 1, 2), cap)
    xe = jax.vmap(lambda xb, ib: xb[ib])(x, idx)
    hdn = jax.nn.silu(jnp.einsum('becd,edf->becf', xe, w1)) * jnp.einsum('becd,edf->becf', xe, w3)
    ye = jnp.einsum('becf,efd->becd', hdn, w2) * gate[..., None].astype(x.dtype)
    bidx = jnp.arange(B)[:, None, None]
    return jnp.zeros_like(x).at[bidx, idx].add(ye)


def per_layer_embedding(h, p_i, g_in, w_gate, w_pe, g_post):
    gate = jax.nn.sigmoid(rmsnorm(h, g_in) @ w_gate)
    e = rmsnorm(p_i @ w_pe, g_post)
    return h + gate * e


def setup_inputs(seed: int = 0) -> dict:
    key = jax.random.key(seed)
    ks = iter(jax.random.split(key, 48))
    f32 = jnp.float32
    nrm = lambda shape, scale: jax.random.normal(next(ks), shape, f32) * scale
    L = DEPTH
    return {
        "x": nrm((BATCH, SEQ, D_MODEL), 1.0),
        "p": nrm((DEPTH, BATCH, SEQ, PLE_DIM), 1.0),
        "rel_bias": nrm((N_BUCKETS, DA_HEADS), 0.5),
        "g_mix": 1.0 + nrm((L, D_MODEL), 0.05),
        "w_in": nrm((L, D_MODEL, IN_COLS), D_MODEL ** -0.5),
        "w_out": nrm((L, MIX_WIDTH, D_MODEL), MIX_WIDTH ** -0.5),
        "q_norm_g": 1.0 + nrm((L, DA_QK), 0.05),
        "k_norm_g": 1.0 + nrm((L, DA_QK), 0.05),
        "lam_q1": nrm((L, DA_QK), 0.1),
        "lam_k1": nrm((L, DA_QK), 0.1),
        "lam_q2": nrm((L, DA_QK), 0.1),
        "lam_k2": nrm((L, DA_QK), 0.1),
        "subln_g": 1.0 + nrm((L, DA_V), 0.05),
        "rw_mu": jax.random.uniform(next(ks), (L, RW_COLS), f32, 0.2, 0.8),
        "rw_w0": jax.random.uniform(next(ks), (L, 2, RW_WIDTH), f32, -6.0, -1.0),
        "rw_w2": nrm((L, 2, DECAY_LORA, RW_WIDTH), 0.1 * DECAY_LORA ** -0.5),
        "rw_a0": nrm((L, 2, RW_WIDTH), 0.1),
        "rw_a2": nrm((L, 2, AAA_LORA, RW_WIDTH), 0.1 * AAA_LORA ** -0.5),
        "rw_g2": nrm((L, GATE_LORA, RW_WIDTH), GATE_LORA ** -0.5),
        "rw_k_k": 0.85 + nrm((L, RW_WIDTH), 0.05),
        "rw_k_a": 1.0 + nrm((L, RW_WIDTH), 0.05),
        "rw_r_k": nrm((L, RW_HEADS, RW_N), 0.1),
        "rw_lnx_g": 1.0 + nrm((L, RW_WIDTH), 0.05),
        "rw_lnx_b": nrm((L, RW_WIDTH), 0.01),
        "g_ffn": 1.0 + nrm((L, D_MODEL), 0.05),
        "w_router": nrm((L, D_MODEL, N_EXPERTS), D_MODEL ** -0.5),
        "w1": nrm((L, N_EXPERTS, D_MODEL, D_FF), D_MODEL ** -0.5),
        "w3": nrm((L, N_EXPERTS, D_MODEL, D_FF), D_MODEL ** -0.5),
        "w2": nrm((L, N_EXPERTS, D_FF, D_MODEL), D_FF ** -0.5),
        "g_ple": 1.0 + nrm((L, D_MODEL), 0.05),
        "w_ple_gate": nrm((L, D_MODEL, D_MODEL), D_MODEL ** -0.5),
        "w_ple": nrm((L, PLE_DIM, D_MODEL), PLE_DIM ** -0.5),
        "g_ple_post": 1.0 + nrm((L, D_MODEL), 0.05),
    }


def reference(x, p, rel_bias, g_mix, w_in, w_out, q_norm_g, k_norm_g, lam_q1, lam_k1, lam_q2,
              lam_k2, subln_g, rw_mu, rw_w0, rw_w2, rw_a0, rw_a2, rw_g2, rw_k_k, rw_k_a, rw_r_k,
              rw_lnx_g, rw_lnx_b, g_ffn, w_router, w1, w3, w2, g_ple, w_ple_gate, w_ple,
              g_ple_post):
    h = x
    for i in range(DEPTH):
        u = rmsnorm(h, g_mix[i]) @ w_in[i]
        u_da, u_rw = u[..., :DA_COLS], u[..., DA_COLS:]
        o_da = diff_attn_mixer(u_da, q_norm_g[i], k_norm_g[i], lam_q1[i], lam_k1[i],
                               lam_q2[i], lam_k2[i], subln_g[i], rel_bias, i)
        o_rw = rwkv7_mixer(u_rw, rw_mu[i], rw_w0[i], rw_w2[i], rw_a0[i], rw_a2[i], rw_g2[i],
                           rw_k_k[i], rw_k_a[i], rw_r_k[i], rw_lnx_g[i], rw_lnx_b[i])
        h = h + jnp.concatenate([o_da, o_rw], axis=-1) @ w_out[i]
        h = h + expert_choice_ffn(rmsnorm(h, g_ffn[i]), w_router[i], w1[i], w3[i], w2[i])
        h = per_layer_embedding(h, p[i], g_ple[i], w_ple_gate[i], w_ple[i], g_ple_post[i])
    return h
```

```cpp
#define PEEL_P1 false
#include <hip/hip_runtime.h>
#include <cstdio>
#include <cstdint>
namespace pg8 {
#define PG8_LAS __attribute__((address_space(3)))
typedef unsigned short bf16_t;
typedef short bf16x8 __attribute__((ext_vector_type(8)));
typedef float f32x4 __attribute__((ext_vector_type(4)));
typedef float f32x2 __attribute__((ext_vector_type(2)));
typedef unsigned u32x4 __attribute__((ext_vector_type(4)));
typedef unsigned u32x2 __attribute__((ext_vector_type(2)));
typedef __bf16 bf16x2_t __attribute__((ext_vector_type(2)));
typedef int v4i __attribute__((ext_vector_type(4)));
typedef int v8i __attribute__((ext_vector_type(8)));
constexpr int BM = 256, BK = 64, HALF = 128, HTB = HALF * BK * 2, STAGE_BYTES = 8 * HTB, NXCD = 8, WGM = 8;

__host__ __device__ __forceinline__ int lds_byte(int r, int c) { const int st = (r >> 4) * 2 + (c >> 5), rr = r & 15, cc = c & 31, ob = rr * 64 + cc * 2; return st * 1024 + (ob ^ (((ob >> 9) & 1) << 5)); }
__host__ __device__ __forceinline__ void stage_rc(int b, int& R, int& C) { const int st = b / 1024, sb = b % 1024, swz = sb ^ (((sb >> 9) & 1) << 5); R = (st >> 1) * 16 + swz / 64; C = (st & 1) * 32 + (swz % 64) / 2; }
__host__ __device__ __forceinline__ int perm32(int rho) { const int n = rho >> 4, i = rho & 15; return 8 * (i >> 2) + 4 * n + (i & 3); }

struct Unit { int pm, pn; };
struct Gemm { const bf16_t* A; const bf16_t* Bt; int M, N, K; int tpg; size_t gstride; const int* arow = nullptr; int tab_off = 0; int wscale = 0x7f7f7f7f; };

struct StaticOrder {
    int nM, nN, nwg, G, c;
    __host__ __device__ void init(int M, int N, int G_, int c_) { nM = M / BM; nN = N / BM; nwg = nM * nN; G = G_; c = c_; }
    __host__ __device__ bool next(int i, Unit& u) const {
        const long L = (long)i * G + c; if (L >= nwg) return false;
        int wgid = (int)L; { const int q = nwg / NXCD, r = nwg % NXCD, xcd = wgid % NXCD, off = wgid / NXCD; wgid = (xcd < r ? xcd * (q + 1) : r * (q + 1) + (xcd - r) * q) + off; }
        const int nig = WGM * nN, gid = wgid / nig, fm = gid * WGM, gsz = (nM - fm) < WGM ? (nM - fm) : WGM;
        u.pm = fm + ((wgid % nig) % gsz); u.pn = (wgid % nig) / gsz; return true;
    }
    __device__ __forceinline__ void a_ready(const Unit&) const {}
    __device__ __forceinline__ void done(const Unit&) const {}
};

__device__ __forceinline__ unsigned cvt_pk_bf16(float lo, float hi) { f32x2 v = {lo, hi}; bf16x2_t b = __builtin_convertvector(v, bf16x2_t); return __builtin_bit_cast(unsigned, b); }
__device__ __forceinline__ float fast_sigmoid(float x) { return __builtin_amdgcn_rcpf(1.0f + __builtin_amdgcn_exp2f(-1.4426950408889634f * x)); }

struct EpiBf16Plain {
    static constexpr bool PERM = true, AFTER_DRAIN = false; static constexpr int NSTORE = 16;
    bf16_t* O; int ldc;
    __device__ __forceinline__ void operator()(const f32x4 (&acc)[2][2][4][2], const Unit& u, int wr, int wc, int fr, int fq) const {
        const int row0 = u.pm * BM + wr * 64 + fr, col0 = u.pn * BM + wc * 32 + 8 * fq;
#pragma unroll
        for (int ai = 0; ai < 2; ++ai)
#pragma unroll
            for (int m = 0; m < 4; ++m) { bf16_t* rowp = O + (size_t)(row0 + ai * HALF + m * 16) * ldc + col0;
#pragma unroll
                for (int bj = 0; bj < 2; ++bj) { const f32x4 v0 = acc[ai][bj][m][0], v1 = acc[ai][bj][m][1];
                    u32x4 w; w.x = cvt_pk_bf16(v0[0], v0[1]); w.y = cvt_pk_bf16(v0[2], v0[3]); w.z = cvt_pk_bf16(v1[0], v1[1]); w.w = cvt_pk_bf16(v1[2], v1[3]);
                    *(u32x4*)(rowp + bj * HALF) = w; } }
    }
};
struct EpiSwiGLU {
    static constexpr bool PERM = true, AFTER_DRAIN = false; static constexpr int NSTORE = 8;
    bf16_t* O; int ldc;
    __device__ __forceinline__ void operator()(const f32x4 (&acc)[2][2][4][2], const Unit& u, int wr, int wc, int fr, int fq) const {
        const int row0 = u.pm * BM + wr * 64 + fr, col0 = u.pn * HALF + wc * 32 + 8 * fq;
#pragma unroll
        for (int ai = 0; ai < 2; ++ai)
#pragma unroll
            for (int m = 0; m < 4; ++m) { bf16_t* rowp = O + (size_t)(row0 + ai * HALF + m * 16) * ldc + col0;
                float r[8];
#pragma unroll
                for (int n = 0; n < 2; ++n)
#pragma unroll
                    for (int j = 0; j < 4; ++j) { const float a = acc[ai][0][m][n][j], b = acc[ai][1][m][n][j]; r[4 * n + j] = a * fast_sigmoid(a) * b; }
                u32x4 w; w.x = cvt_pk_bf16(r[0], r[1]); w.y = cvt_pk_bf16(r[2], r[3]); w.z = cvt_pk_bf16(r[4], r[5]); w.w = cvt_pk_bf16(r[6], r[7]);
                *(u32x4*)rowp = w; }
    }
};
__device__ __forceinline__ unsigned cvt4_fp8(float a, float b, float c, float d) { int w = 0; w = __builtin_amdgcn_cvt_pk_fp8_f32(a, b, w, false); w = __builtin_amdgcn_cvt_pk_fp8_f32(c, d, w, true); return (unsigned)w; }
struct EpiSwiGLU8 {
    static constexpr bool PERM = true, AFTER_DRAIN = false; static constexpr int NSTORE = 8;
    unsigned char* O; int ldc;
    __device__ __forceinline__ void operator()(const f32x4 (&acc)[2][2][4][2], const Unit& u, int wr, int wc, int fr, int fq) const {
        const int row0 = u.pm * BM + wr * 64 + fr, col0 = u.pn * HALF + wc * 32 + 8 * fq;
#pragma unroll
        for (int ai = 0; ai < 2; ++ai)
#pragma unroll
            for (int m = 0; m < 4; ++m) { unsigned char* rowp = O + (size_t)(row0 + ai * HALF + m * 16) * ldc + col0;
                float r[8];
#pragma unroll
                for (int n = 0; n < 2; ++n)
#pragma unroll
                    for (int j = 0; j < 4; ++j) { const float a = acc[ai][0][m][n][j], b = acc[ai][1][m][n][j]; r[4 * n + j] = a * fast_sigmoid(a) * b; }
                u32x2 w; w.x = cvt4_fp8(r[0], r[1], r[2], r[3]); w.y = cvt4_fp8(r[4], r[5], r[6], r[7]);
                *(u32x2*)rowp = w; }
    }
};
struct EpiRowScaleBf16 {
    static constexpr bool PERM = true, AFTER_DRAIN = false; static constexpr int NSTORE = 16;
    bf16_t* O; int ldc; const float* scale;
    __device__ __forceinline__ void operator()(const f32x4 (&acc)[2][2][4][2], const Unit& u, int wr, int wc, int fr, int fq) const {
        const int row0 = u.pm * BM + wr * 64 + fr, col0 = u.pn * BM + wc * 32 + 8 * fq;
#pragma unroll
        for (int ai = 0; ai < 2; ++ai)
#pragma unroll
            for (int m = 0; m < 4; ++m) { const int row = row0 + ai * HALF + m * 16; const float sc = scale[row]; bf16_t* rowp = O + (size_t)row * ldc + col0;
#pragma unroll
                for (int bj = 0; bj < 2; ++bj) { const f32x4 v0 = acc[ai][bj][m][0] * sc, v1 = acc[ai][bj][m][1] * sc;
                    u32x4 w; w.x = cvt_pk_bf16(v0[0], v0[1]); w.y = cvt_pk_bf16(v0[2], v0[3]); w.z = cvt_pk_bf16(v1[0], v1[1]); w.w = cvt_pk_bf16(v1[2], v1[3]);
                    *(u32x4*)(rowp + bj * HALF) = w; } }
    }
};
struct EpiResF32 {
    static constexpr bool PERM = false, AFTER_DRAIN = false; static constexpr int NSTORE = 16;
    const float* base; float* out; int ldc;
    __device__ __forceinline__ void operator()(const f32x4 (&acc)[2][2][4][2], const Unit& u, int wr, int wc, int fr, int fq) const {
        const int row0 = u.pm * BM + wr * 64 + fr, col0 = u.pn * BM + wc * 32 + 4 * fq;
#pragma unroll
        for (int ai = 0; ai < 2; ++ai)
#pragma unroll
            for (int m = 0; m < 4; ++m) { const size_t off = (size_t)(row0 + ai * HALF + m * 16) * ldc + col0;
#pragma unroll
                for (int bj = 0; bj < 2; ++bj)
#pragma unroll
                    for (int n = 0; n < 2; ++n) { const f32x4 bs = *(const f32x4*)(base + off + bj * HALF + n * 16); *(f32x4*)(out + off + bj * HALF + n * 16) = bs + acc[ai][bj][m][n]; } }
    }
};
struct EpiResBf16 {
    static constexpr bool PERM = false, AFTER_DRAIN = false; static constexpr int NSTORE = 16;
    const float* base; bf16_t* out; int ldc;
    __device__ __forceinline__ void operator()(const f32x4 (&acc)[2][2][4][2], const Unit& u, int wr, int wc, int fr, int fq) const {
        const int row0 = u.pm * BM + wr * 64 + fr, col0 = u.pn * BM + wc * 32 + 4 * fq;
#pragma unroll
        for (int ai = 0; ai < 2; ++ai)
#pragma unroll
            for (int m = 0; m < 4; ++m) { const size_t off = (size_t)(row0 + ai * HALF + m * 16) * ldc + col0;
#pragma unroll
                for (int bj = 0; bj < 2; ++bj)
#pragma unroll
                    for (int n = 0; n < 2; ++n) { const f32x4 v = *(const f32x4*)(base + off + bj * HALF + n * 16) + acc[ai][bj][m][n];
                        u32x2 w; w.x = cvt_pk_bf16(v[0], v[1]); w.y = cvt_pk_bf16(v[2], v[3]); *(u32x2*)(out + off + bj * HALF + n * 16) = w; } }
    }
};
struct EpiPleFinal {
    static constexpr bool PERM = false, AFTER_DRAIN = false; static constexpr int NSTORE = 16;
    const bf16_t* h2; float* out; int ldc; const bf16_t* pe; const float* prs; const float* gp;
    __device__ __forceinline__ void operator()(const f32x4 (&acc)[2][2][4][2], const Unit& u, int wr, int wc, int fr, int fq) const {
        const int row0 = u.pm * BM + wr * 64 + fr, col0 = u.pn * BM + wc * 32 + 4 * fq;
        f32x4 g4[2][2];
#pragma unroll
        for (int bj = 0; bj < 2; ++bj)
#pragma unroll
            for (int n = 0; n < 2; ++n) g4[bj][n] = *(const f32x4*)(gp + col0 + bj * HALF + n * 16);
#pragma unroll
        for (int ai = 0; ai < 2; ++ai)
#pragma unroll
            for (int m = 0; m < 4; ++m) { const int row = row0 + ai * HALF + m * 16; const size_t off = (size_t)row * ldc + col0; const float rs = prs[row];
#pragma unroll
                for (int bj = 0; bj < 2; ++bj)
#pragma unroll
                    for (int n = 0; n < 2; ++n) { const size_t o2 = off + bj * HALF + n * 16; const u32x2 hw = *(const u32x2*)(h2 + o2); const u32x2 pw = *(const u32x2*)(pe + o2);
                        f32x4 hv, e; hv[0] = __uint_as_float(hw.x << 16); hv[1] = __uint_as_float(hw.x & 0xffff0000u); hv[2] = __uint_as_float(hw.y << 16); hv[3] = __uint_as_float(hw.y & 0xffff0000u);
                        e[0] = __uint_as_float(pw.x << 16); e[1] = __uint_as_float(pw.x & 0xffff0000u); e[2] = __uint_as_float(pw.y << 16); e[3] = __uint_as_float(pw.y & 0xffff0000u);
                        const f32x4 a = acc[ai][bj][m][n]; f32x4 o;
#pragma unroll
                        for (int j = 0; j < 4; ++j) o[j] = hv[j] + fast_sigmoid(a[j]) * (e[j] * rs * g4[bj][n][j]);
                        *(f32x4*)(out + o2) = o; } }
    }
};
template <class Epi, class Sched, bool ALIGN_EPI = false, bool SP2 = false, bool GATHER = false, bool FP8 = false, bool PEEL = false>
__device__ __forceinline__ void gemm_phase(PG8_LAS unsigned char* lds, const Gemm g, const Sched& S, const Epi& E) {
    const int tid = threadIdx.x, wid = __builtin_amdgcn_readfirstlane(tid >> 6), lane = tid & 63, wr = wid >> 2, wc = wid & 3, fr = lane & 15, fq = lane >> 4;
    const int K = g.K, nt = K / BK;
    unsigned voffA[2], voffB[2];
#pragma unroll
    for (int i = 0; i < 2; ++i) { int R, C; stage_rc(tid * 16 + i * 8192, R, C); const int Rb = Epi::PERM ? ((R & ~31) + perm32(R & 31)) : R;
        voffA[i] = (unsigned)(R * K + C) * 2u; voffB[i] = (unsigned)(Rb * K + C) * 2u; }
    static_assert(!GATHER || SP2, "gathered A rows: SP2 loop only");
    int gR[2], gC[2];
#pragma unroll
    for (int i = 0; i < 2; ++i) stage_rc(tid * 16 + i * 8192, gR[i], gC[i]);
    unsigned vAc[2][2], vAn[2][2], vS[2][2];
#pragma unroll
    for (int hf = 0; hf < 2; ++hf)
#pragma unroll
        for (int i = 0; i < 2; ++i) { vAc[hf][i] = 0u; vAn[hf][i] = 0u; vS[hf][i] = 0u; }
    const size_t kstep = (size_t)(BK * 2);
    const size_t hstep = (size_t)HALF * K * 2;
    const size_t hstepA = GATHER ? 0 : hstep;
    const size_t tstep = 2 * hstep;
    const unsigned ldsw = (unsigned)wid * 1024u;
    const int aoff = FP8 ? lds_byte(wr * 64 + fr, 16 * (fq & 1)) + (fq >> 1) * 1024 : lds_byte(wr * 64 + fr, fq * 8);
    const int boff = FP8 ? lds_byte(wc * 32 + fr, 16 * (fq & 1)) + (fq >> 1) * 1024 : lds_byte(wc * 32 + fr, fq * 8);

#define PG8_SA(b, h) (((b) * 2 + (h)) * HTB)
#define PG8_SB(b, h) ((4 + (b) * 2 + (h)) * HTB)
#define PG8_STAGE(bufoff, gbase, voff) do { _Pragma("unroll") for (int _i = 0; _i < 2; ++_i) \
        __builtin_amdgcn_global_load_lds((const unsigned*)((const char*)(gbase) + (voff)[_i]), (PG8_LAS unsigned*)(lds + (bufoff) + ldsw + _i * 8192), 16, 0, 0); } while (0)
#define PG8_LD8(p_) __builtin_shufflevector(*(const PG8_LAS v4i*)(p_), *(const PG8_LAS v4i*)((p_) + 16), 0, 1, 2, 3, 4, 5, 6, 7)
#define PG8_LDA(dst, b, h) do { if constexpr (FP8) { _Pragma("unroll") for (int m = 0; m < 4; ++m) dst##8[m] = PG8_LD8(lds + PG8_SA(b, h) + aoff + m * 2048); } \
        else { _Pragma("unroll") for (int m = 0; m < 4; ++m) _Pragma("unroll") for (int k = 0; k < 2; ++k) dst[m][k] = *(const PG8_LAS bf16x8*)(lds + PG8_SA(b, h) + aoff + m * 2048 + k * 1024); } } while (0)
#define PG8_LDB(dst, b, h) do { if constexpr (FP8) { _Pragma("unroll") for (int n = 0; n < 2; ++n) dst##8[n] = PG8_LD8(lds + PG8_SB(b, h) + boff + n * 2048); } \
        else { _Pragma("unroll") for (int n = 0; n < 2; ++n) _Pragma("unroll") for (int k = 0; k < 2; ++k) dst[n][k] = *(const PG8_LAS bf16x8*)(lds + PG8_SB(b, h) + boff + n * 2048 + k * 1024); } } while (0)
#define PG8_MMA(ai, bj, At, Bt) do { __builtin_amdgcn_s_setprio(1); _Pragma("unroll") for (int m = 0; m < 4; ++m) _Pragma("unroll") for (int n = 0; n < 2; ++n) { \
        if constexpr (FP8) asm volatile("s_nop 1\n\tv_mfma_scale_f32_16x16x128_f8f6f4 %0, %1, %2, %0, %3, %4 op_sel_hi:[0,0,0]" : "+v"(acc[ai][bj][m][n]) : "v"(Bt##8[n]), "v"(At##8[m]), "v"(wsc_), "v"(asc_));     \
        else { _Pragma("unroll") for (int k = 0; k < 2; ++k) acc[ai][bj][m][n] = __builtin_amdgcn_mfma_f32_16x16x32_bf16(Bt[n][k], At[m][k], acc[ai][bj][m][n], 0, 0, 0); } } \
        __builtin_amdgcn_s_setprio(0); } while (0)
#define PG8_WAIT_V(n) asm volatile("s_waitcnt vmcnt(" #n ")" ::: "memory")
#define PG8_WAIT_V1 do { if (PEEL && first_) { if constexpr (Epi::NSTORE == 16) asm volatile("s_waitcnt vmcnt(24)" ::: "memory"); else asm volatile("s_waitcnt vmcnt(16)" ::: "memory"); } else asm volatile("s_waitcnt vmcnt(8)" ::: "memory"); } while (0)
#define PG8_WAIT_L(n) asm volatile("s_waitcnt lgkmcnt(" #n ")" ::: "memory")
#define PG8_BAR __builtin_amdgcn_s_barrier()
#define PG8_SCHED __builtin_amdgcn_sched_barrier(0)
    Unit cur, nxt; int ui = 0;
    if (!S.next(0, cur)) return;
    f32x4 acc[2][2][4][2];
#pragma unroll
    for (int a = 0; a < 2; ++a)
#pragma unroll
        for (int b = 0; b < 2; ++b)
#pragma unroll
            for (int m = 0; m < 4; ++m)
#pragma unroll
                for (int n = 0; n < 2; ++n) acc[a][b][m][n] = (f32x4){0.f, 0.f, 0.f, 0.f};
    int wsc_ = g.wscale, asc_ = 0x7f7f7f7f; asm volatile("" : "+v"(wsc_), "+v"(asc_));
    bf16x8 At[4][2], B0[2][2], B1[2][2]; v8i At8[4], B08[2], B18[2];
    if constexpr (GATHER) {
        PG8_LAS int* tab = (PG8_LAS int*)(lds + g.tab_off); Unit uu;
        for (int i = 0; S.next(i, uu); ++i) for (int r = tid; r < BM; r += 512) tab[i * BM + r] = g.arow[(size_t)uu.pm * BM + r];
        asm volatile("s_waitcnt vmcnt(0) lgkmcnt(0)" ::: "memory"); __builtin_amdgcn_s_barrier(); asm volatile("" ::: "memory");
#pragma unroll
        for (int hf = 0; hf < 2; ++hf)
#pragma unroll
            for (int i = 0; i < 2; ++i) vAc[hf][i] = ((unsigned)tab[hf * HALF + gR[i]] * (unsigned)K + (unsigned)gC[i]) * 2u;
    }
    const char* cA = (const char*)g.A + (GATHER ? (size_t)0 : (size_t)cur.pm * tstep); const char* cB = (const char*)g.Bt + (size_t)(cur.pm / g.tpg) * g.gstride + (size_t)cur.pn * tstep;
    S.a_ready(cur);
    if constexpr (SP2) {
        PG8_STAGE(PG8_SB(0, 0), cB, voffB); PG8_STAGE(PG8_SB(0, 1), cB + hstep, voffB); PG8_STAGE(PG8_SA(0, 0), cA, (GATHER ? vAc[0] : voffA)); PG8_STAGE(PG8_SA(0, 1), cA + hstepA, (GATHER ? vAc[1] : voffA));
        if (wr == 1) PG8_BAR;
        PG8_WAIT_V(2); PG8_BAR;
        PG8_STAGE(PG8_SB(1, 0), cB + kstep, voffB); PG8_STAGE(PG8_SA(1, 0), cA + kstep, (GATHER ? vAc[0] : voffA)); PG8_STAGE(PG8_SB(1, 1), cB + hstep + kstep, voffB);
        PG8_WAIT_V(6); PG8_BAR;
    } else {
        PG8_STAGE(PG8_SB(0, 0), cB, voffB); PG8_STAGE(PG8_SA(0, 0), cA, voffA); PG8_STAGE(PG8_SB(0, 1), cB + hstep, voffB); PG8_STAGE(PG8_SA(0, 1), cA + hstep, voffA);
        if (wr == 1) PG8_BAR;
        PG8_WAIT_V(4); PG8_BAR;
        PG8_STAGE(PG8_SB(1, 0), cB + kstep, voffB); PG8_STAGE(PG8_SA(1, 0), cA + kstep, voffA); PG8_STAGE(PG8_SB(1, 1), cB + hstep + kstep, voffB);
        PG8_WAIT_V(6); PG8_BAR;
    }
    for (;;) {
        const bool has_next = S.next(ui + 1, nxt);
        const char* nA = (has_next && !GATHER) ? (const char*)g.A + (size_t)nxt.pm * tstep : cA; const char* nB = has_next ? (const char*)g.Bt + (size_t)(nxt.pm / g.tpg) * g.gstride + (size_t)nxt.pn * tstep : cB;
        if constexpr (GATHER) { PG8_LAS int* tab = (PG8_LAS int*)(lds + g.tab_off);
#pragma unroll
            for (int hf = 0; hf < 2; ++hf)
#pragma unroll
                for (int i = 0; i < 2; ++i) vAn[hf][i] = has_next ? ((unsigned)tab[(ui + 1) * BM + hf * HALF + gR[i]] * (unsigned)K + (unsigned)gC[i]) * 2u : vAc[hf][i]; }
        for (int t = 0; t < nt; t += 2) {
            const bool last = (t == nt - 2);
            const bool first_ = (t == 0) && (ui > 0);
            if constexpr (GATHER) {
#pragma unroll
                for (int hf = 0; hf < 2; ++hf)
#pragma unroll
                    for (int i = 0; i < 2; ++i) vS[hf][i] = last ? vAn[hf][i] : vAc[hf][i]; }
            const char* a1 = cA + (size_t)(t + 1) * kstep;
            const char* a2 = last ? nA : cA + (size_t)(t + 2) * kstep; const char* b2 = last ? nB : cB + (size_t)(t + 2) * kstep;
            const char* a3 = a2 + kstep; const char* b3 = b2 + kstep;
            if (last && has_next) S.a_ready(nxt);
            if constexpr (SP2) {
            PG8_LDB(B0, 0, 0); PG8_LDB(B1, 0, 1); PG8_SCHED; PG8_LDA(At, 0, 0); PG8_STAGE(PG8_SA(1, 1), a1 + hstepA, (GATHER ? vAc[1] : voffA));
            PG8_WAIT_V1; PG8_WAIT_L(0); PG8_BAR; PG8_MMA(0, 0, At, B0); PG8_MMA(0, 1, At, B1); PG8_BAR; PG8_SCHED;
            PG8_LDA(At, 0, 1); PG8_STAGE(PG8_SB(0, 0), b2, voffB); PG8_STAGE(PG8_SB(0, 1), b2 + hstep, voffB); PG8_STAGE(PG8_SA(0, 0), a2, (GATHER ? vS[0] : voffA));
            PG8_WAIT_V1; PG8_WAIT_L(0); PG8_BAR; PG8_MMA(1, 0, At, B0); PG8_MMA(1, 1, At, B1); PG8_BAR; PG8_SCHED;
            PG8_LDB(B0, 1, 0); PG8_LDB(B1, 1, 1); PG8_SCHED; PG8_LDA(At, 1, 0); PG8_STAGE(PG8_SA(0, 1), a2 + hstepA, (GATHER ? vS[1] : voffA));
            PG8_WAIT_V(8); PG8_WAIT_L(0); PG8_BAR; PG8_MMA(0, 0, At, B0); PG8_MMA(0, 1, At, B1); PG8_BAR; PG8_SCHED;
            PG8_LDA(At, 1, 1); PG8_STAGE(PG8_SB(1, 0), b3, voffB); PG8_STAGE(PG8_SB(1, 1), b3 + hstep, voffB); PG8_STAGE(PG8_SA(1, 0), a3, (GATHER ? vS[0] : voffA));
            PG8_WAIT_V(8); PG8_WAIT_L(0); PG8_BAR; PG8_MMA(1, 0, At, B0); PG8_MMA(1, 1, At, B1); PG8_BAR; PG8_SCHED;
            } else {
            PG8_LDB(B0, 0, 0); PG8_SCHED; PG8_LDA(At, 0, 0); PG8_STAGE(PG8_SA(1, 1), a1 + hstep, voffA);
            PG8_WAIT_L(8); PG8_BAR; PG8_WAIT_L(0); PG8_MMA(0, 0, At, B0); PG8_BAR; PG8_SCHED;
            PG8_LDB(B1, 0, 1); PG8_STAGE(PG8_SB(0, 0), b2, voffB);
            PG8_BAR; PG8_WAIT_L(0); PG8_MMA(0, 1, At, B1); PG8_BAR;
            PG8_LDA(At, 0, 1); PG8_STAGE(PG8_SA(0, 0), a2, voffA);
            PG8_BAR; PG8_WAIT_L(0); PG8_MMA(1, 0, At, B0); PG8_BAR; PG8_SCHED;
            PG8_STAGE(PG8_SB(0, 1), b2 + hstep, voffB);
            PG8_WAIT_V(6); PG8_BAR; PG8_MMA(1, 1, At, B1); PG8_BAR;
            PG8_LDB(B0, 1, 0); PG8_SCHED; PG8_LDA(At, 1, 0); PG8_STAGE(PG8_SA(0, 1), a2 + hstep, voffA);
            PG8_WAIT_L(8); PG8_BAR; PG8_WAIT_L(0); PG8_MMA(0, 0, At, B0); PG8_BAR; PG8_SCHED;
            PG8_LDB(B1, 1, 1); PG8_STAGE(PG8_SB(1, 0), b3, voffB);
            PG8_BAR; PG8_WAIT_L(0); PG8_MMA(0, 1, At, B1); PG8_BAR;
            PG8_LDA(At, 1, 1); PG8_STAGE(PG8_SA(1, 0), a3, voffA);
            PG8_BAR; PG8_WAIT_L(0); PG8_MMA(1, 0, At, B0); PG8_BAR; PG8_SCHED;
            PG8_STAGE(PG8_SB(1, 1), b3 + hstep, voffB);
            PG8_WAIT_V(6); PG8_BAR; PG8_MMA(1, 1, At, B1); PG8_BAR;
            }
        }
        if constexpr (ALIGN_EPI) { if (wr == 0) PG8_BAR; }
        if constexpr (FP8) {
            asm volatile("s_nop 15\n\ts_nop 15" : "+v"(acc[0][0][0][0]), "+v"(acc[0][0][0][1]), "+v"(acc[0][0][1][0]), "+v"(acc[0][0][1][1]), "+v"(acc[0][0][2][0]), "+v"(acc[0][0][2][1]), "+v"(acc[0][0][3][0]), "+v"(acc[0][0][3][1]),
                         "+v"(acc[0][1][0][0]), "+v"(acc[0][1][0][1]), "+v"(acc[0][1][1][0]), "+v"(acc[0][1][1][1]), "+v"(acc[0][1][2][0]), "+v"(acc[0][1][2][1]), "+v"(acc[0][1][3][0]), "+v"(acc[0][1][3][1]));
            asm volatile("" : "+v"(acc[1][0][0][0]), "+v"(acc[1][0][0][1]), "+v"(acc[1][0][1][0]), "+v"(acc[1][0][1][1]), "+v"(acc[1][0][2][0]), "+v"(acc[1][0][2][1]), "+v"(acc[1][0][3][0]), "+v"(acc[1][0][3][1]),
                         "+v"(acc[1][1][0][0]), "+v"(acc[1][1][0][1]), "+v"(acc[1][1][1][0]), "+v"(acc[1][1][1][1]), "+v"(acc[1][1][2][0]), "+v"(acc[1][1][2][1]), "+v"(acc[1][1][3][0]), "+v"(acc[1][1][3][1])); }
        if constexpr (!Epi::AFTER_DRAIN) { E(acc, cur, wr, wc, fr, fq); S.done(cur); }
        if (!has_next) break;
#pragma unroll
        for (int a = 0; a < 2; ++a)
#pragma unroll
            for (int b = 0; b < 2; ++b)
#pragma unroll
                for (int m = 0; m < 4; ++m)
#pragma unroll
                    for (int n = 0; n < 2; ++n) acc[a][b][m][n] = (f32x4){0.f, 0.f, 0.f, 0.f};
        cur = nxt; cA = nA; cB = nB; ++ui;
        if constexpr (GATHER) {
#pragma unroll
            for (int hf = 0; hf < 2; ++hf)
#pragma unroll
                for (int i = 0; i < 2; ++i) vAc[hf][i] = vAn[hf][i]; }
        if constexpr (ALIGN_EPI) { if (wr == 1) PG8_BAR; }
    }
    PG8_WAIT_V(0);
    if constexpr (!ALIGN_EPI) { if (wr == 0) PG8_BAR; }
    PG8_BAR;
    if constexpr (Epi::AFTER_DRAIN) { E.fused(acc, cur, wr, wc, fr, fq, lds, wid, lane); S.done(cur); }
#undef PG8_SA
#undef PG8_SB
#undef PG8_STAGE
#undef PG8_LD8
#undef PG8_LDA
#undef PG8_LDB
#undef PG8_MMA
#undef PG8_WAIT_V
#undef PG8_WAIT_V1
#undef PG8_WAIT_L
#undef PG8_BAR
#undef PG8_SCHED
}
}
constexpr int NB = 16, SEQ = 2048, DM = 1024, MT = NB * SEQ;
constexpr int INC = 3488, INCP = 3584;
constexpr int NE = 16, CAP = 256, DFF = 2048, NGRP = 2, EPG = NE / NGRP, MG = EPG * NB * CAP;
constexpr int C_Q = 0, C_K = 512, C_V = 1024, C_RW = 1536, C_RR = 1536, C_RK = 2048, C_RV = 2560, C_WL = 3072, C_AL = 3200, C_GL = 3328;
constexpr float NORM_EPS = 1e-6f, RW_LN_EPS = 64e-5f, LOG2E = 1.4426950408889634f;
constexpr int NWAVES = 8, NTHR = 512;
enum { I_X = 0, I_P, I_RELB, I_GMIX, I_WIN, I_WOUT, I_QG, I_KG, I_LQ1, I_LK1, I_LQ2, I_LK2, I_SUBLN, I_MU, I_W0, I_W2L, I_A0, I_A2L, I_G2L, I_KK, I_KA, I_RK, I_LNG, I_LNB,
       I_GFFN, I_WR, I_W1, I_W3, I_W2, I_GPLE, I_WPG, I_WPLE, I_GPOST, N_IN };
constexpr size_t MiB = 1u << 20;
constexpr size_t WS_CTL = 0, CTL_ZERO_BYTES = 1 * MiB;
constexpr size_t WS_WIN = 1 * MiB, WS_WOUT = 8 * MiB, WS_WPG = 10 * MiB, WS_WPLE = 12 * MiB;
constexpr size_t WS_LW2 = 12 * MiB + 512 * 1024, WS_LA2 = WS_LW2 + 131072, WS_LG2 = WS_LA2 + 131072;
constexpr size_t WS_XN = 14 * MiB, WS_QN = 14 * MiB, WS_KN = 46 * MiB;
constexpr size_t WS_HB = 14 * MiB;
constexpr size_t WS_H2B = 334 * MiB;
constexpr size_t WS_HN8 = 430 * MiB;
constexpr size_t WS_U = 78 * MiB;
constexpr size_t WS_W13 = 78 * MiB, WS_W2T = 142 * MiB;
constexpr size_t WS_YE = 174 * MiB;
constexpr size_t WS_HDN = 302 * MiB;
constexpr size_t WS_HN2 = 302 * MiB;
constexpr size_t WS_VT = 302 * MiB, WS_MIX = 334 * MiB, WS_Y = 398 * MiB, WS_BON = 526 * MiB, WS_PB = 544 * MiB;
constexpr size_t WS_PE = 462 * MiB;
constexpr size_t WS_AFF = 526 * MiB, WS_SEL = 528 * MiB, WS_RMAP = 530 * MiB, WS_GATE = WS_RMAP + 262144, WS_PERS = WS_GATE + 262144;
constexpr int TAB_OFF = 132096;
constexpr size_t WS_END = 560 * MiB;
constexpr int CW_TMO = 0, CW_CODE = 1, CW_BAR = 4096;
constexpr int RING_OFF = 0, RING_BYTES = 131072, LDSCTL_OFF = RING_BYTES, MISC_OFF = LDSCTL_OFF + 320, LDS_BYTES = 147456;

#define GAS __attribute__((address_space(1)))
#define LAS __attribute__((address_space(3)))
typedef unsigned short bf16;
typedef unsigned v4u __attribute__((ext_vector_type(4)));
typedef unsigned v2u __attribute__((ext_vector_type(2)));
typedef float f32x4 __attribute__((ext_vector_type(4)));
typedef float f32x16 __attribute__((ext_vector_type(16)));
typedef short bf16x8 __attribute__((ext_vector_type(8)));
typedef GAS unsigned gu32;
#define RLX_AGENT __ATOMIC_RELAXED, __HIP_MEMORY_SCOPE_AGENT
#define LDS_WAIT() asm volatile("s_waitcnt lgkmcnt(0)" ::: "memory")
#define VM_WAIT() asm volatile("s_waitcnt vmcnt(0)" ::: "memory")
#define WG_BAR() do { asm volatile("s_waitcnt lgkmcnt(0)" ::: "memory"); __builtin_amdgcn_s_barrier(); asm volatile("" ::: "memory"); } while (0)
#define MFMA32(a, b, c) __builtin_amdgcn_mfma_f32_32x32x16_bf16((a), (b), (c), 0, 0, 0)
using pg8::cvt_pk_bf16; using pg8::fast_sigmoid;
__device__ __forceinline__ float bflo(unsigned w) { return __builtin_bit_cast(float, w << 16); }
__device__ __forceinline__ float bfhi(unsigned w) { return __builtin_bit_cast(float, w & 0xffff0000u); }
__device__ __forceinline__ void unpack8(const v4u w, float (&f)[8]) { f[0] = bflo(w.x); f[1] = bfhi(w.x); f[2] = bflo(w.y); f[3] = bfhi(w.y); f[4] = bflo(w.z); f[5] = bfhi(w.z); f[6] = bflo(w.w); f[7] = bfhi(w.w); }
__device__ __forceinline__ v4u pack8(const float (&f)[8]) { v4u w; w.x = cvt_pk_bf16(f[0], f[1]); w.y = cvt_pk_bf16(f[2], f[3]); w.z = cvt_pk_bf16(f[4], f[5]); w.w = cvt_pk_bf16(f[6], f[7]); return w; }
__device__ __forceinline__ float fexp2(float x) { return __builtin_amdgcn_exp2f(x); }
__device__ __forceinline__ float frcp(float x) { return __builtin_amdgcn_rcpf(x); }
__device__ __forceinline__ float wave_sum(float v) {
#pragma unroll
    for (int o = 1; o < 64; o <<= 1) v += __shfl_xor(v, o);
    return v;
}
template <int CTRL> __device__ __forceinline__ float dpp_f(float x) { return __builtin_bit_cast(float, __builtin_amdgcn_update_dpp(0, __builtin_bit_cast(int, x), CTRL, 0xF, 0xF, true)); }
__device__ __forceinline__ float sum8(float p) { p += dpp_f<0xB1>(p); p += dpp_f<0x4E>(p); p += dpp_f<0x141>(p); return p; }

#define XB_TMO      128
#define XB_XCNT(j)  (256  + 64 * (j))
#define XB_XSUB(j)  (1280 + 64 * (j))
#define XB_XGEN(j)  (2304 + 64 * (j))
#define XB_TOP      3328
#define XB_TOPGEN   3392
#define XCD_BAR_WORDS 3456
#define XB_SPIN_CAP (1u << 18)
__device__ __forceinline__ unsigned xb_ld(unsigned* p)              { return __hip_atomic_load(p, __ATOMIC_RELAXED, __HIP_MEMORY_SCOPE_AGENT); }
__device__ __forceinline__ unsigned xb_add(unsigned* p, unsigned v) { return __hip_atomic_fetch_add(p, v, __ATOMIC_RELAXED, __HIP_MEMORY_SCOPE_AGENT); }
__device__ __forceinline__ unsigned xb_xcc_id() { return (unsigned)__builtin_amdgcn_s_getreg((3 << 11) | 20) & 0xFu; }
#define XB_SPIN(cond, bar) do { unsigned _sp = 0; while (cond) { __builtin_amdgcn_s_sleep(1); \
    if ((++_sp & 255u) == 0u) { if (xb_ld(&(bar)[XB_TMO])) break; if (_sp > XB_SPIN_CAP) { atomicAdd(&(bar)[XB_TMO], 1u); break; } } } } while (0)
struct XcdBarrier { unsigned* bar; unsigned x; volatile LAS unsigned* st; };
__device__ __forceinline__ XcdBarrier xcd_barrier_post(unsigned* bar, volatile LAS unsigned* st) {
    XcdBarrier b; b.bar = bar; b.x = xb_xcc_id(); b.st = st;
    if (threadIdx.x == 0) (void)xb_add(&bar[XB_XCNT(b.x)], 1u);
    return b;
}
__device__ __forceinline__ void xcd_barrier_complete(unsigned* bar, unsigned x, unsigned& nloc, unsigned& nx) {
    const unsigned G = gridDim.x * gridDim.y * gridDim.z;
    unsigned sum, cnt, mine, sp = 0u;
    for (;;) {
        sum = 0u; cnt = 0u; mine = 0u;
#pragma unroll
        for (unsigned j = 0; j < 16; ++j) { const unsigned c = xb_ld(&bar[XB_XCNT(j)]); sum += c; cnt += (c > 0u) ? 1u : 0u; mine = (j == x) ? c : mine; }
        if (sum == G) break;
        __builtin_amdgcn_s_sleep(1);
        if ((++sp & 255u) == 0u) { if (xb_ld(&bar[XB_TMO])) break; if (sp > XB_SPIN_CAP) { atomicAdd(&bar[XB_TMO], 1u); break; } }
    }
    nloc = mine > 0u ? mine : 1u; nx = cnt > 0u ? cnt : 1u;
}
__device__ __forceinline__ void xcd_barrier(const XcdBarrier& b) {
    asm volatile("s_waitcnt vmcnt(0)" ::: "memory");
    __syncthreads();
    if (threadIdx.x == 0) {
        unsigned* bar = b.bar;
        __builtin_amdgcn_s_waitcnt(0);
        unsigned nloc = b.st[0], nx = b.st[1];
        if (nloc == 0u) { xcd_barrier_complete(bar, b.x, nloc, nx); b.st[0] = nloc; b.st[1] = nx; }
        const unsigned old = xb_add(&bar[XB_XSUB(b.x)], 1u);
        const unsigned gen = old / nloc;
        if (old + 1u == (gen + 1u) * nloc) {
            __builtin_amdgcn_fence(__ATOMIC_RELEASE, "agent");
            asm volatile("s_waitcnt vmcnt(0)" ::: "memory");
            const unsigned og = xb_add(&bar[XB_TOP], 1u);
            const unsigned tg = og / nx;
            if (og + 1u == (tg + 1u) * nx) xb_add(&bar[XB_TOPGEN], 1u);
            else XB_SPIN(xb_ld(&bar[XB_TOPGEN]) == tg, bar);
            __builtin_amdgcn_fence(__ATOMIC_ACQUIRE, "agent");
            xb_add(&bar[XB_XGEN(b.x)], 1u);
            asm volatile("s_waitcnt vmcnt(0)" ::: "memory");
        } else {
            XB_SPIN(xb_ld(&bar[XB_XGEN(b.x)]) == gen, bar);
            __builtin_amdgcn_fence(__ATOMIC_ACQUIRE, "agent");
            asm volatile("s_waitcnt vmcnt(0)" ::: "memory");
        }
    }
    __syncthreads();
}

struct Args { const float* in[N_IN]; float* out; unsigned char* ws; int ph_lo, ph_hi, li, pad; };
struct Ctx { LAS unsigned char* lds; int tid, lane, wave, G, vcu; };

__device__ __forceinline__ void transpose_item(const float* W, int N, bf16* WT, int ldo, int dest_row0, int k0, int n0, LAS float* scr, int lane) {
#pragma unroll 8
    for (int i = 0; i < 32; ++i) { const int kk = 2 * i + (lane >> 5); scr[kk * 33 + (lane & 31)] = W[(size_t)(k0 + kk) * N + n0 + (lane & 31)]; }
    LDS_WAIT(); asm volatile("" ::: "memory");
    const int c = lane & 7;
#pragma unroll
    for (int j = 0; j < 4; ++j) { const int n = (lane >> 3) + 8 * j; const LAS float* s = scr + (8 * c) * 33 + n;
        v4u o; o.x = cvt_pk_bf16(s[0 * 33], s[1 * 33]); o.y = cvt_pk_bf16(s[2 * 33], s[3 * 33]); o.z = cvt_pk_bf16(s[4 * 33], s[5 * 33]); o.w = cvt_pk_bf16(s[6 * 33], s[7 * 33]);
        *(GAS v4u*)(WT + (size_t)(dest_row0 + n) * ldo + k0 + 8 * c) = o; }
    LDS_WAIT(); asm volatile("" ::: "memory");
}
__device__ __forceinline__ void transpose_item_fp8(const float* W, int N, unsigned char* WT, int ldo, int dest_row0, int k0, int n0, float scale, LAS float* scr, int lane) {
#pragma unroll 8
    for (int i = 0; i < 32; ++i) { const int kk = 2 * i + (lane >> 5); scr[kk * 33 + (lane & 31)] = W[(size_t)(k0 + kk) * N + n0 + (lane & 31)]; }
    LDS_WAIT(); asm volatile("" ::: "memory");
    const int c = lane & 3;
#pragma unroll
    for (int j = 0; j < 2; ++j) { const int n = (lane >> 2) + 16 * j; const LAS float* sp = scr + (16 * c) * 33 + n;
        v4u o; o.x = pg8::cvt4_fp8(sp[0 * 33] * scale, sp[1 * 33] * scale, sp[2 * 33] * scale, sp[3 * 33] * scale); o.y = pg8::cvt4_fp8(sp[4 * 33] * scale, sp[5 * 33] * scale, sp[6 * 33] * scale, sp[7 * 33] * scale);
        o.z = pg8::cvt4_fp8(sp[8 * 33] * scale, sp[9 * 33] * scale, sp[10 * 33] * scale, sp[11 * 33] * scale); o.w = pg8::cvt4_fp8(sp[12 * 33] * scale, sp[13 * 33] * scale, sp[14 * 33] * scale, sp[15 * 33] * scale);
        *(GAS v4u*)(WT + (size_t)(dest_row0 + n) * ldo + k0 + 16 * c) = o; }
    LDS_WAIT(); asm volatile("" ::: "memory");
}
constexpr float WSCALE = 32.0f; constexpr int WSCALE_E8M0 = 0x7a7a7a7a;
__device__ __forceinline__ void p0_prologue(const Args& a, const Ctx& F) {
    unsigned char* ws = a.ws;
    LAS float* scr = (LAS float*)(F.lds + RING_OFF + F.wave * 16384);
    const int gw = F.vcu * NWAVES + F.wave, NGW = F.G * NWAVES;
    constexpr int I0 = 16 * 109, I1 = I0 + 512, I2 = I1 + 512, I3 = I2 + 128, I4 = I3 + 32, I5 = I4 + 32;
    for (int it = gw; it < I5; it += NGW) {
        if (it < I0) { const int kb = it / 109, nb = it % 109; transpose_item(a.in[I_WIN], INC, (bf16*)(ws + WS_WIN), DM, 32 * nb, 64 * kb, 32 * nb, scr, F.lane); }
        else if (it < I1) { const int r = it - I0, kb = r >> 5, nb = r & 31; transpose_item(a.in[I_WOUT], DM, (bf16*)(ws + WS_WOUT), DM, 32 * nb, 64 * kb, 32 * nb, scr, F.lane); }
        else if (it < I2) { const int r = it - I1, kb = r >> 5, nb = r & 31; transpose_item_fp8(a.in[I_WPG], DM, ws + WS_WPG, DM, 32 * nb, 64 * kb, 32 * nb, WSCALE, scr, F.lane); }
        else if (it < I3) { const int r = it - I2, kb = r >> 5, nb = r & 31; transpose_item(a.in[I_WPLE], DM, (bf16*)(ws + WS_WPLE), 256, 32 * nb, 64 * kb, 32 * nb, scr, F.lane); }
        else if (it < I4) { const int r = it - I3, d = r >> 4, nb = r & 15; transpose_item(a.in[I_W2L] + (size_t)d * 64 * 512, 512, (bf16*)(ws + WS_LW2) + (size_t)d * 512 * 64, 64, 32 * nb, 0, 32 * nb, scr, F.lane); }
        else { const int r = it - I4, d = r >> 4, nb = r & 15; transpose_item(a.in[I_A2L] + (size_t)d * 64 * 512, 512, (bf16*)(ws + WS_LA2) + (size_t)d * 512 * 64, 64, 32 * nb, 0, 32 * nb, scr, F.lane); }
    }
    const int gt = F.vcu * NTHR + F.tid, NGT = F.G * NTHR;
    for (int i = gt; i < (INCP - INC) * DM / 8; i += NGT) *(GAS v4u*)((bf16*)(ws + WS_WIN) + (size_t)INC * DM + (size_t)i * 8) = (v4u){0u, 0u, 0u, 0u};
    for (int i = gt; i < 512 * 192; i += NGT) { const int n = i / 192, k = i % 192; const float v = k < 160 ? a.in[I_G2L][(size_t)k * 512 + n] : 0.f; ((bf16*)(ws + WS_LG2))[i] = (bf16)(cvt_pk_bf16(v, 0.f) & 0xffffu); }
    for (int i = gt; i < MT * 256 / 8; i += NGT) { const f32x4 x0 = *(const GAS f32x4*)(a.in[I_P] + (size_t)i * 8), x1 = *(const GAS f32x4*)(a.in[I_P] + (size_t)i * 8 + 4);
        v4u o; o.x = cvt_pk_bf16(x0[0], x0[1]); o.y = cvt_pk_bf16(x0[2], x0[3]); o.z = cvt_pk_bf16(x1[0], x1[1]); o.w = cvt_pk_bf16(x1[2], x1[3]); *(GAS v4u*)((bf16*)(ws + WS_PB) + (size_t)i * 8) = o; }
    const float* gm = a.in[I_GMIX];
    for (int m = gw; m < MT; m += NGW) {
        const GAS f32x4* xr = (const GAS f32x4*)(a.in[I_X] + (size_t)m * DM) + F.lane;
        f32x4 v[4]; float s = 0.f;
#pragma unroll
        for (int j = 0; j < 4; ++j) { v[j] = xr[64 * j]; s += (v[j][0] * v[j][0] + v[j][1] * v[j][1]) + (v[j][2] * v[j][2] + v[j][3] * v[j][3]); }
        const float rstd = 1.0f / sqrtf(wave_sum(s) * (1.f / DM) + NORM_EPS);
        GAS v2u* o8 = (GAS v2u*)((bf16*)(ws + WS_XN) + (size_t)m * DM) + F.lane;
#pragma unroll
        for (int j = 0; j < 4; ++j) { const f32x4 g = *(const f32x4*)(gm + 4 * F.lane + 256 * j); v2u o; o.x = cvt_pk_bf16(v[j][0] * rstd * g[0], v[j][1] * rstd * g[1]); o.y = cvt_pk_bf16(v[j][2] * rstd * g[2], v[j][3] * rstd * g[3]); o8[64 * j] = o; }
    }
}
__device__ __forceinline__ void p5_expert_weights(const Args& a, const Ctx& F) {
    unsigned char* ws = a.ws;
    LAS float* scr = (LAS float*)(F.lds + RING_OFF + F.wave * 16384);
    const int gw = F.vcu * NWAVES + F.wave, NGW = F.G * NWAVES;
    constexpr int PER_E = 3 * 1024;
    for (int it = gw; it < NE * PER_E; it += NGW) {
        const int e = it / PER_E, r = it % PER_E;
        if (r < 2048) { const int w3 = r >> 10, q = r & 1023, kb = q >> 6, nb = q & 63, n0 = 32 * nb;
            transpose_item_fp8(a.in[w3 ? I_W3 : I_W1] + (size_t)e * DM * DFF, DFF, ws + WS_W13 + (size_t)e * 4096 * DM, DM, 256 * (n0 >> 7) + (n0 & 127) + 128 * w3, 64 * kb, n0, WSCALE, scr, F.lane); }
        else { const int q = r - 2048, kb = q >> 5, nb = q & 31;
            transpose_item_fp8(a.in[I_W2] + (size_t)e * DFF * DM, DM, ws + WS_W2T + (size_t)e * DM * DFF, DFF, 32 * nb, 64 * kb, 32 * nb, WSCALE, scr, F.lane); }
    }
}
__device__ __forceinline__ void p2_attn_prep(const Args& a, const Ctx& F) {
    unsigned char* ws = a.ws; const bf16* U = (const bf16*)(ws + WS_U);
    bf16* QN = (bf16*)(ws + WS_QN); bf16* KN = (bf16*)(ws + WS_KN); bf16* VT = (bf16*)(ws + WS_VT);
    const int lane = F.lane, sv = lane >> 2, d0 = (lane & 3) * 16;
    float gq[16];
    { const float* g = (sv < 8) ? a.in[I_QG] : a.in[I_KG]; const float sc = (sv < 8) ? 0.125f * LOG2E : 1.0f;
#pragma unroll
      for (int i = 0; i < 16; ++i) gq[i] = g[d0 + i] * sc; }
    for (int u = F.vcu; u < MT / 64; u += F.G) {
        const int m0 = u * 64, b = m0 / SEQ, s0 = m0 % SEQ;
#pragma unroll 2
        for (int i = 0; i < 8; ++i) { const int tk = F.wave * 8 + i; const bf16* row = U + (size_t)(m0 + tk) * INCP + lane * 16;
            const v4u w0 = *(const GAS v4u*)row, w1 = *(const GAS v4u*)(row + 8);
            float x[16]; { float t0[8], t1[8]; unpack8(w0, t0); unpack8(w1, t1);
#pragma unroll
              for (int j = 0; j < 8; ++j) { x[j] = t0[j]; x[8 + j] = t1[j]; } }
            float ss = 0.f;
#pragma unroll
            for (int j = 0; j < 16; ++j) ss += x[j] * x[j];
            ss += dpp_f<0xB1>(ss); ss += dpp_f<0x4E>(ss);
            const float rn = 1.0f / sqrtf(ss * (1.f / 64.f) + NORM_EPS);
            float y0[8], y1[8];
#pragma unroll
            for (int j = 0; j < 8; ++j) { y0[j] = x[j] * rn * gq[j]; y1[j] = x[8 + j] * rn * gq[8 + j]; }
            const int svl = sv & 7, hh = svl >> 1, c = svl & 1;
            bf16* dst = ((sv < 8) ? QN : KN) + ((size_t)((b * 4 + hh) * 2 + c) * SEQ + s0 + tk) * 64 + d0;
            *(GAS v4u*)dst = pack8(y0); *(GAS v4u*)(dst + 8) = pack8(y1); }
        LAS unsigned char* T = F.lds + RING_OFF;
#pragma unroll
        for (int i = 0; i < 8; ++i) { const int p = F.tid + 512 * i, tk = p >> 6, ch = p & 63;
            const v4u w = *(const GAS v4u*)(U + (size_t)(m0 + tk) * INCP + C_V + ch * 8); *(LAS v4u*)(T + tk * 1040 + ch * 16) = w; }
        LDS_WAIT(); __syncthreads();
        { const int dv = F.tid;
          bf16* dst = VT + ((size_t)(b * 4 + (dv >> 7)) * 128 + (dv & 127)) * SEQ + s0;
#pragma unroll
          for (int g = 0; g < 8; ++g) { unsigned short e[8];
#pragma unroll
              for (int j = 0; j < 8; ++j) e[j] = *(const LAS unsigned short*)(T + (8 * g + j) * 1040 + dv * 2);
              v4u o; o.x = e[0] | ((unsigned)e[1] << 16); o.y = e[2] | ((unsigned)e[3] << 16); o.z = e[4] | ((unsigned)e[5] << 16); o.w = e[6] | ((unsigned)e[7] << 16);
              *(GAS v4u*)(dst + 8 * g) = o; } }
        LDS_WAIT(); __syncthreads();
    }
}

__device__ __forceinline__ void mix8(const bf16* Ub, int t, int col, const float* mu, float (&x)[8]) {
    const v4u z = {0u, 0u, 0u, 0u};
    const v4u w0 = *(const GAS v4u*)(Ub + (size_t)t * INCP + col);
    const v4u wm = (t > 0) ? *(const GAS v4u*)(Ub + (size_t)(t - 1) * INCP + col) : z;
    const v4u wp = (t < SEQ - 1) ? *(const GAS v4u*)(Ub + (size_t)(t + 1) * INCP + col) : z;
    const f32x4 m0 = *(const f32x4*)(mu + col - C_RW), m1 = *(const f32x4*)(mu + col - C_RW + 4);
    float u0[8], um[8], up[8]; unpack8(w0, u0); unpack8(wm, um); unpack8(wp, up);
#pragma unroll
    for (int j = 0; j < 8; ++j) { const float mj = j < 4 ? m0[j] : m1[j - 4]; x[j] = u0[j] + mj * (0.5f * (um[j] + up[j]) - u0[j]); }
}
__device__ __forceinline__ int t5_bucket(int rel) {
    const int n = rel < 0 ? -rel : rel; const int ret = rel > 0 ? 16 : 0;
    int lg = 8 + (n >= 12) + (n >= 16) + (n >= 23) + (n >= 32) + (n >= 46) + (n >= 64) + (n >= 91); lg = lg < 15 ? lg : 15;
    return ret + (n < 8 ? n : lg);
}
__device__ __forceinline__ int swz(int row, int chunk) { return row * 128 + ((chunk ^ ((row >> 1) & 7)) << 4); }
__device__ __forceinline__ void p3_attn_unit(const Args& a, const Ctx& F, int unit, float lam) {
    unsigned char* ws = a.ws;
    const int b = unit >> 6, h = (unit >> 4) & 3, qt = unit & 15, q0 = qt * 128;
    int tid_ = F.tid, wave_ = F.wave; asm volatile("" : "+v"(tid_), "+s"(wave_));
    const int tid = tid_, lane = tid & 63, wave = wave_, c = wave >> 2, qw = wave & 3, l31 = lane & 31, hh = lane >> 5;
    const bf16* KNb = (const bf16*)(ws + WS_KN) + (size_t)((b * 4 + h) * 2) * SEQ * 64;
    const bf16* VTb = (const bf16*)(ws + WS_VT) + (size_t)(b * 4 + h) * 128 * SEQ;
    LAS unsigned char* KV = F.lds + RING_OFF;
    LAS float* BT = (LAS float*)(F.lds + RING_OFF + 65536);
    const float* relb = a.in[I_RELB];
    for (int i = tid; i < 641; i += NTHR) BT[i] = relb[t5_bucket(i - 320) * 4 + h] * LOG2E;
    const float cL = relb[15 * 4 + h] * LOG2E, cR = relb[31 * 4 + h] * LOG2E;
    bf16x8 qf[4];
    { const bf16* Qp = (const bf16*)(ws + WS_QN) + ((size_t)((b * 4 + h) * 2 + c) * SEQ + q0 + 32 * qw + l31) * 64 + 8 * hh;
#pragma unroll
      for (int ks = 0; ks < 4; ++ks) qf[ks] = *(const GAS bf16x8*)(Qp + 16 * ks); }
    const bf16* gsrc[4]; int ldst[4];
#pragma unroll
    for (int i = 0; i < 4; ++i) { const int p = tid + 512 * i;
        if (p < 1024) { const int cc = p >> 9, row = (p & 511) >> 3, ch = p & 7; gsrc[i] = KNb + ((size_t)cc * SEQ + row) * 64 + ch * 8; ldst[i] = cc * 8192 + swz(row, ch); }
        else { const int q = p - 1024, row = q >> 3, ch = q & 7; gsrc[i] = VTb + (size_t)row * SEQ + ch * 8; ldst[i] = 16384 + swz(row, ch); } }
    const int pr = (l31 & 19) | ((l31 & 4) << 1) | ((l31 & 8) >> 1);
    f32x16 O[4];
#pragma unroll
    for (int d = 0; d < 4; ++d)
#pragma unroll
        for (int i = 0; i < 16; ++i) O[d][i] = 0.f;
    float mrun = -1e30f, lrun = 0.f;
    const int qpos = q0 + 32 * qw + l31;
    v4u stg[4];
#pragma unroll
    for (int i = 0; i < 4; ++i) stg[i] = *(const GAS v4u*)(gsrc[i] + (i < 2 ? 0 : 0));
#pragma unroll
    for (int i = 0; i < 4; ++i) *(LAS v4u*)(KV + ldst[i]) = stg[i];
    LDS_WAIT(); __syncthreads();
    for (int t = 0; t < SEQ / 64; ++t) {
        const int k0 = t * 64; LAS unsigned char* buf = KV + (t & 1) * 32768;
        if (t + 1 < SEQ / 64) {
#pragma unroll
            for (int i = 0; i < 4; ++i) stg[i] = *(const GAS v4u*)(gsrc[i] + (i < 2 ? (size_t)(k0 + 64) * 64 : (size_t)(k0 + 64)));
        }
        f32x16 st[2];
#pragma unroll
        for (int kt = 0; kt < 2; ++kt)
#pragma unroll
            for (int i = 0; i < 16; ++i) st[kt][i] = 0.f;
#pragma unroll
        for (int ks = 0; ks < 4; ++ks)
#pragma unroll
            for (int kt = 0; kt < 2; ++kt) { const bf16x8 kf = *(const LAS bf16x8*)(buf + c * 8192 + swz(32 * kt + pr, 2 * ks + hh)); st[kt] = MFMA32(kf, qf[ks], st[kt]); }
        const int relmax = k0 + 63 - q0, relmin = k0 - q0 - 127;
        float cb = 0.f;
        if (relmax <= -91) cb = cL; else if (relmin >= 91) cb = cR;
        else { int boff_ = (k0 - qpos + 320 + 8 * hh) * 4 + 65536; asm volatile("" : "+v"(boff_)); const LAS float* btp_ = (const LAS float*)(F.lds + RING_OFF + boff_);
#pragma unroll
            for (int kt = 0; kt < 2; ++kt)
#pragma unroll
                for (int r = 0; r < 16; ++r) st[kt][r] += btp_[32 * kt + 16 * (r >> 3) + (r & 7)];
        }
        float mx = st[0][0];
#pragma unroll
        for (int kt = 0; kt < 2; ++kt)
#pragma unroll
            for (int r = 0; r < 16; ++r) mx = fmaxf(mx, st[kt][r]);
        mx += cb;
        mx = fmaxf(mx, __shfl_xor(mx, 32));
        if (__any(mx - mrun > 8.0f)) {
            const float mnew = fmaxf(mrun, mx), alpha = fexp2(mrun - mnew); mrun = mnew; lrun *= alpha;
#pragma unroll
            for (int d = 0; d < 4; ++d)
#pragma unroll
                for (int i = 0; i < 16; ++i) O[d][i] *= alpha; }
        const float sub = cb - mrun;
        float ps = 0.f;
#pragma unroll
        for (int kt = 0; kt < 2; ++kt)
#pragma unroll
            for (int r = 0; r < 16; ++r) { st[kt][r] = fexp2(st[kt][r] + sub); ps += st[kt][r]; }
        lrun += ps;
        bf16x8 pf[2][2];
#pragma unroll
        for (int kt = 0; kt < 2; ++kt)
#pragma unroll
            for (int s2 = 0; s2 < 2; ++s2) { v4u w; w.x = cvt_pk_bf16(st[kt][8 * s2 + 0], st[kt][8 * s2 + 1]); w.y = cvt_pk_bf16(st[kt][8 * s2 + 2], st[kt][8 * s2 + 3]); w.z = cvt_pk_bf16(st[kt][8 * s2 + 4], st[kt][8 * s2 + 5]); w.w = cvt_pk_bf16(st[kt][8 * s2 + 6], st[kt][8 * s2 + 7]);
                pf[kt][s2] = __builtin_bit_cast(bf16x8, w); }
#pragma unroll
        for (int kt = 0; kt < 2; ++kt)
#pragma unroll
            for (int s2 = 0; s2 < 2; ++s2)
#pragma unroll
                for (int d = 0; d < 4; ++d) { const bf16x8 vf = *(const LAS bf16x8*)(buf + 16384 + swz(32 * d + l31, 4 * kt + 2 * s2 + hh)); O[d] = MFMA32(vf, pf[kt][s2], O[d]); }
        if (t + 1 < SEQ / 64) { LAS unsigned char* nb = KV + ((t + 1) & 1) * 32768;
#pragma unroll
            for (int i = 0; i < 4; ++i) *(LAS v4u*)(nb + ldst[i]) = stg[i]; }
        LDS_WAIT(); __syncthreads();
    }
    const float ltot = lrun + __shfl_xor(lrun, 32), linv = 1.0f / ltot;
    LAS float* X = (LAS float*)(F.lds + RING_OFF);
    if (c == 1) {
        const float sc = lam * linv;
#pragma unroll
        for (int d = 0; d < 4; ++d)
#pragma unroll
            for (int r = 0; r < 16; ++r) X[((qw * 4 + d) * 16 + r) * 64 + lane] = O[d][r] * sc;
    }
    LDS_WAIT(); __syncthreads();
    if (c == 0) {
        float ssq = 0.f;
#pragma unroll
        for (int d = 0; d < 4; ++d)
#pragma unroll
            for (int r = 0; r < 16; ++r) { const float o = O[d][r] * linv - X[((qw * 4 + d) * 16 + r) * 64 + lane]; O[d][r] = o; ssq += o * o; }
        ssq += __shfl_xor(ssq, 32);
        const float rn = (1.0f / sqrtf(ssq * (1.f / 128.f) + NORM_EPS)) * 0.8f;
        const float* sg = a.in[I_SUBLN];
        bf16* orow = (bf16*)(ws + WS_MIX) + (size_t)(b * SEQ + qpos) * DM + h * 128;
#pragma unroll
        for (int d = 0; d < 4; ++d)
#pragma unroll
            for (int g = 0; g < 4; ++g) { const int dv = 32 * d + 8 * g + 4 * hh; const f32x4 gg = *(const f32x4*)(sg + dv);
                v2u w; w.x = cvt_pk_bf16(O[d][4 * g] * rn * gg[0], O[d][4 * g + 1] * rn * gg[1]); w.y = cvt_pk_bf16(O[d][4 * g + 2] * rn * gg[2], O[d][4 * g + 3] * rn * gg[3]);
                *(GAS v2u*)(orow + dv) = w; }
    }
    LDS_WAIT(); __syncthreads();
}
#ifndef NEU_STAGES
#define NEU_STAGES 2
#endif
namespace rw {
constexpr int SLOT = 8192;
constexpr int IM_QH = 0, IM_RH = 1, IM_KT = 2, IM_BT = 3, IM_KTT = 4, IM_BTT = 5, IM_VT = 6, IM_S0 = 7, IM_RHS = 7, IM_ABQ = 8, IM_ABQT = 9, IM_AKQ = 10, IM_UT = 10, IM_AKR = 11, IM_ABR = 12,
              IM_TA = 13, IM_TB = 14, IM_PA = 0, IM_PB = 2, IM_TW = 12, IM_AL = 6;
constexpr int OFF_YC = 13 * SLOT, OFF_LW = 8 * SLOT, OFF_LA = 10 * SLOT, OFF_MISC = 15 * SLOT;
enum Mask { M_NONE = 0, M_LT = 1, M_LE = 2, M_GT = 3 };
__device__ __forceinline__ f32x16 zero16() { f32x16 z;
#pragma unroll
    for (int i = 0; i < 16; ++i) z[i] = 0.f; return z; }
__device__ __forceinline__ f32x16 mm_tile(const LAS unsigned char* X, int xr0, const LAS unsigned char* Y, int yr0, f32x16 acc, int l31, int hh) {
    bf16x8 af[4], bf_[4];
#pragma unroll
    for (int s = 0; s < 4; ++s) { af[s] = *(const LAS bf16x8*)(X + swz(xr0 + l31, 2 * s + hh)); bf_[s] = *(const LAS bf16x8*)(Y + swz(yr0 + l31, 2 * s + hh)); }
    asm volatile("s_waitcnt lgkmcnt(0)" : "+v"(af[0]), "+v"(af[1]), "+v"(af[2]), "+v"(af[3]), "+v"(bf_[0]), "+v"(bf_[1]), "+v"(bf_[2]), "+v"(bf_[3]));
#pragma unroll
    for (int s = 0; s < 4; ++s) acc = MFMA32(af[s], bf_[s], acc);
    return acc;
}
template <int MODE> __device__ __forceinline__ void store_T(LAS unsigned char* img, const f32x16& d, int r0, int c0, int l31, int hh) {
    const int c = c0 + l31;
#pragma unroll
    for (int g = 0; g < 4; ++g) { float v[4];
#pragma unroll
        for (int j = 0; j < 4; ++j) { const int r = r0 + 8 * g + 4 * hh + j; const bool keep = MODE == M_NONE ? true : MODE == M_LT ? (r < c) : MODE == M_LE ? (r <= c) : (c < r); v[j] = keep ? d[4 * g + j] : 0.f; }
        v2u w; w.x = cvt_pk_bf16(v[0], v[1]); w.y = cvt_pk_bf16(v[2], v[3]);
        *(LAS v2u*)(img + swz(c, (r0 >> 3) + g) + 8 * hh) = w; }
}
__device__ __forceinline__ f32x16 load_T(const LAS unsigned char* img, int r0, int c0, int l31, int hh) {
    f32x16 d; const int c = c0 + l31;
#pragma unroll
    for (int g = 0; g < 4; ++g) { const v2u w = *(const LAS v2u*)(img + swz(c, (r0 >> 3) + g) + 8 * hh); d[4 * g] = bflo(w.x); d[4 * g + 1] = bfhi(w.x); d[4 * g + 2] = bflo(w.y); d[4 * g + 3] = bfhi(w.y); }
    return d;
}
__device__ __forceinline__ void put16(LAS unsigned char* img, int row, int col, float v) { *(LAS unsigned short*)(img + swz(row, col >> 3) + (col & 7) * 2) = (unsigned short)(cvt_pk_bf16(v, 0.f) & 0xffffu); }
}

struct MixRaw { v4u w0, wm, wp; };
__device__ __forceinline__ void mix_load(const bf16* Ub, int t, int col, MixRaw& r) {
    const v4u z = {0u, 0u, 0u, 0u};
    r.w0 = *(const GAS v4u*)(Ub + (size_t)t * INCP + col);
    r.wm = (t > 0) ? *(const GAS v4u*)(Ub + (size_t)(t - 1) * INCP + col) : z;
    r.wp = (t < SEQ - 1) ? *(const GAS v4u*)(Ub + (size_t)(t + 1) * INCP + col) : z;
}
__device__ __forceinline__ void mix_compute(const MixRaw& r, const LAS float* mul, float (&x)[8]) {
    const f32x4 m0 = *(const LAS f32x4*)mul, m1 = *(const LAS f32x4*)(mul + 4);
    float u0[8], um[8], up[8]; unpack8(r.w0, u0); unpack8(r.wm, um); unpack8(r.wp, up);
#pragma unroll
    for (int j = 0; j < 8; ++j) { const float mj = j < 4 ? m0[j] : m1[j - 4]; x[j] = u0[j] + mj * (0.5f * (um[j] + up[j]) - u0[j]); }
}
__device__ __forceinline__ void p3_scan_unit_chunked(const Args& a, const Ctx& F, int unit) {
    using namespace rw;
    unsigned char* ws = a.ws;
    int tid_ = F.tid, wave_ = F.wave; asm volatile("" : "+v"(tid_), "+s"(wave_));
    const int dir = unit >> 7, b = (unit >> 3) & 15, h = unit & 7, tid = tid_, lane = tid & 63, wave = wave_, l31 = lane & 31, hh = lane >> 5;
    const bf16* Ub = (const bf16*)(ws + WS_U) + (size_t)b * SEQ * INCP;
    bf16* Y = (bf16*)(ws + WS_Y) + ((size_t)dir * MT + (size_t)b * SEQ) * 512 + h * 64;
    float* BON = (float*)(ws + WS_BON) + ((size_t)dir * MT + (size_t)b * SEQ) * 8 + h;
    LAS unsigned char* L = F.lds + RING_OFF;
#define IMG(s) (L + (s) * SLOT)
    LAS float* YC = (LAS float*)(L + OFF_YC); LAS float* LW = (LAS float*)(L + OFF_LW); LAS float* LA = (LAS float*)(L + OFF_LA);
    LAS float* WLAST = (LAS float*)(L + OFF_MISC); LAS float* WTOT = (LAS float*)(L + OFF_MISC + 256);
    const float* mu = a.in[I_MU];
    const int mat = wave >> 2, ti = (wave >> 1) & 1, ci = wave & 1;
    const bf16* LWp = (const bf16*)(ws + (mat ? WS_LA2 : WS_LW2)) + ((size_t)dir * 512 + h * 64 + 32 * ci + l31) * 64 + 8 * hh;
    const float c0 = (mat ? a.in[I_A0] : a.in[I_W0])[dir * 512 + h * 64 + 32 * ci + l31];
    const int fi = tid >> 3, c8 = tid & 7, fc = c8 * 8;
    const int w4 = wave & 3, tb = w4 >> 1, vb = w4 & 1;
    f32x16 acc_s = zero16();
    for (int i = tid; i < SLOT / 16; i += NTHR) *(LAS v4u*)(IMG(IM_S0) + i * 16) = (v4u){0u, 0u, 0u, 0u};
    LAS float* MUL = (LAS float*)(L + OFF_MISC + 2560);
    const int gcol0 = C_RR + h * 64, gcol1 = C_RK + h * 64, gcol2 = C_RV + h * 64, gcol3 = C_WL + dir * 64, gcol4 = C_AL + dir * 64;
    if (tid < 320) { const int g = tid >> 6, cc = tid & 63; MUL[tid] = mu[(g == 0 ? gcol0 : g == 1 ? gcol1 : g == 2 ? gcol2 : g == 3 ? gcol3 : gcol4) - C_RW + cc]; }
    else if (tid < 512) { const int g = (tid - 320) >> 6, cc = tid & 63; MUL[tid] = (g == 0 ? a.in[I_KK] : g == 1 ? a.in[I_KA] : a.in[I_RK])[h * 64 + cc]; }
    MixRaw R0, R1, R2;
    { const int t0 = dir ? (SEQ - 1 - fi) : fi; mix_load(Ub, t0, gcol0 + fc, R0); mix_load(Ub, t0, gcol1 + fc, R1); mix_load(Ub, t0, gcol2 + fc, R2); }
    WG_BAR();
    for (int chn = 0; chn < SEQ / 64; ++chn) {
        const int sidx = chn * 64 + fi, t = dir ? (SEQ - 1 - sidx) : sidx;
        bf16x8 bfr[4];
#pragma unroll
        for (int ks = 0; ks < 4; ++ks) bfr[ks] = *(const GAS bf16x8*)(LWp + 16 * ks);
        float r8[8], k8[8], v8[8];
        mix_compute(R0, MUL + fc, r8); mix_compute(R1, MUL + 64 + fc, k8); mix_compute(R2, MUL + 128 + fc, v8);
        { MixRaw R3, R4; mix_load(Ub, t, gcol3 + fc, R3); mix_load(Ub, t, gcol4 + fc, R4);
          float x[8]; mix_compute(R3, MUL + 192 + fc, x);
#pragma unroll
          for (int j = 0; j < 8; ++j) x[j] = 1.0f - 2.0f * frcp(1.0f + fexp2(2.0f * LOG2E * x[j]));
          *(LAS v4u*)(IMG(IM_TW) + swz(fi, c8)) = pack8(x);
          mix_compute(R4, MUL + 256 + fc, x); *(LAS v4u*)(IMG(IM_AL) + swz(fi, c8)) = pack8(x); }
        if (chn + 1 < SEQ / 64) { const int s1 = (chn + 1) * 64 + fi, t1 = dir ? (SEQ - 1 - s1) : s1;
            mix_load(Ub, t1, gcol0 + fc, R0); mix_load(Ub, t1, gcol1 + fc, R1); mix_load(Ub, t1, gcol2 + fc, R2); }
        WG_BAR();
        { f32x16 acc = zero16();
#pragma unroll
          for (int ks = 0; ks < 4; ++ks) { const bf16x8 af = *(const LAS bf16x8*)(IMG(mat ? IM_AL : IM_TW) + swz(32 * ti + l31, 2 * ks + hh)); acc = MFMA32(af, bfr[ks], acc); }
          LAS float* dst = mat ? LA : LW;
#pragma unroll
          for (int r = 0; r < 16; ++r) dst[(32 * ti + (r & 3) + 8 * (r >> 2) + 4 * hh) * 64 + 32 * ci + l31] = acc[r] + c0; }
        WG_BAR();
        float lw2[8], av[8], kkv[8], kd[8], bb[8];
        { const f32x4 w0 = *(LAS f32x4*)(LW + fi * 64 + fc), w1 = *(LAS f32x4*)(LW + fi * 64 + fc + 4), a0 = *(LAS f32x4*)(LA + fi * 64 + fc), a1 = *(LAS f32x4*)(LA + fi * 64 + fc + 4);
          float ssq = 0.f, bon = 0.f;
#pragma unroll
          for (int j = 0; j < 8; ++j) { const float wl = j < 4 ? w0[j] : w1[j - 4], al = j < 4 ? a0[j] : a1[j - 4];
              lw2[j] = -0.60653065971f * LOG2E * fast_sigmoid(wl); av[j] = fast_sigmoid(al);
              kkv[j] = k8[j] * MUL[320 + fc + j]; ssq += kkv[j] * kkv[j]; kd[j] = k8[j] * (1.0f + (av[j] - 1.0f) * MUL[384 + fc + j]); bon += r8[j] * kd[j] * MUL[448 + fc + j]; }
          ssq = sum8(ssq); bon = sum8(bon);
          const float inv = 1.0f / fmaxf(sqrtf(ssq), 1e-12f);
#pragma unroll
          for (int j = 0; j < 8; ++j) { kkv[j] *= inv; bb[j] = kkv[j] * av[j]; }
          if (c8 == 0) BON[(size_t)t * 8] = bon; }
        float cum[8];
#pragma unroll
        for (int j = 0; j < 8; ++j) { float x = lw2[j]; float y = __shfl_up(x, 8); if (lane >= 8) x += y; y = __shfl_up(x, 16); if (lane >= 16) x += y; y = __shfl_up(x, 32); if (lane >= 32) x += y; cum[j] = x; }
        if (lane >= 56) {
#pragma unroll
            for (int j = 0; j < 8; ++j) WTOT[wave * 64 + fc + j] = cum[j]; }
        WG_BAR();
#pragma unroll 1
        for (int w = 0; w < wave; ++w) { const f32x4 t0 = *(LAS f32x4*)(WTOT + w * 64 + fc), t1 = *(LAS f32x4*)(WTOT + w * 64 + fc + 4);
#pragma unroll
            for (int j = 0; j < 4; ++j) { cum[j] += t0[j]; cum[4 + j] += t1[j]; } }
        { float qh[8], rh[8], kt[8], bt[8];
#pragma unroll
          for (int j = 0; j < 8; ++j) { const float W = fexp2(cum[j]), Wm = fexp2(cum[j] - lw2[j]), Wi = fexp2(-cum[j]);
              qh[j] = kkv[j] * Wm; rh[j] = r8[j] * W; kt[j] = kd[j] * Wi; bt[j] = bb[j] * Wi;
              if (fi == 63) WLAST[fc + j] = W; }
          *(LAS v4u*)(IMG(IM_QH) + swz(fi, c8)) = pack8(qh); *(LAS v4u*)(IMG(IM_RH) + swz(fi, c8)) = pack8(rh);
          *(LAS v4u*)(IMG(IM_KT) + swz(fi, c8)) = pack8(kt); *(LAS v4u*)(IMG(IM_BT) + swz(fi, c8)) = pack8(bt);
#pragma unroll
          for (int j = 0; j < 8; ++j) { put16(IMG(IM_KTT), fc + j, fi, kt[j]); put16(IMG(IM_BTT), fc + j, fi, bt[j]); put16(IMG(IM_VT), fc + j, fi, v8[j]); } }
        WG_BAR();
        f32x16 acc_t;
        acc_t = mm_tile(IMG(wave < 4 ? IM_QH : IM_RH), 32 * tb, IMG(IM_S0), 32 * vb, zero16(), l31, hh);
#pragma unroll 1
        for (int tt = wave; tt < 20; tt += 8) { const int p = tt >> 2, rb = (tt >> 1) & 1, cb = tt & 1;
            const int xs = (p == 0 || p == 2) ? IM_KT : (p == 4 ? IM_QH : IM_BT), ys = (p == 0 || p == 1) ? IM_QH : (p == 4 ? IM_BT : IM_RH);
            const f32x16 d = mm_tile(IMG(xs), 32 * rb, IMG(ys), 32 * cb, zero16(), l31, hh);
            if (p == 0) store_T<M_LT>(IMG(IM_AKQ), d, 32 * rb, 32 * cb, l31, hh);
            else if (p == 1) { store_T<M_LT>(IMG(IM_ABQ), d, 32 * rb, 32 * cb, l31, hh);
                f32x16 t1;
#pragma unroll
                for (int q = 0; q < 16; ++q) { const int r = 32 * rb + (q & 3) + 8 * (q >> 2) + 4 * hh, c = 32 * cb + l31; t1[q] = (r == c ? 1.0f : 0.f) - (r < c ? d[q] : 0.f); }
                store_T<M_NONE>(IMG(IM_TA), t1, 32 * rb, 32 * cb, l31, hh); }
            else if (p == 2) store_T<M_LE>(IMG(IM_AKR), d, 32 * rb, 32 * cb, l31, hh);
            else if (p == 3) store_T<M_LE>(IMG(IM_ABR), d, 32 * rb, 32 * cb, l31, hh);
            else store_T<M_GT>(IMG(IM_ABQT), d, 32 * rb, 32 * cb, l31, hh); }
        WG_BAR();
        if (wave < 4) { acc_t = mm_tile(IMG(IM_AKQ), 32 * tb, IMG(IM_VT), 32 * vb, acc_t, l31, hh); store_T<M_NONE>(IMG(IM_RHS), acc_t, 32 * tb, 32 * vb, l31, hh); }
        else {
#pragma unroll 1
            for (int q = 0; q < 2; ++q) { const int tt = 2 * w4 + q, tr = (tt >> 1) & 1, rb = (tt >> 2), cb = tt & 1;
                const f32x16 d = mm_tile(IMG(tr ? IM_ABQ : IM_ABQT), 32 * rb, IMG(tr ? IM_ABQT : IM_ABQ), 32 * cb, zero16(), l31, hh);
                store_T<M_NONE>(IMG(IM_PA + tr), d, 32 * rb, 32 * cb, l31, hh); } }
        WG_BAR();
#pragma unroll 1
        for (int st = 0; st < NEU_STAGES; ++st) {
            const int pc = (st & 1) ? IM_PB : IM_PA, pn = (st & 1) ? IM_PA : IM_PB, tc = (st & 1) ? IM_TB : IM_TA, tn = (st & 1) ? IM_TA : IM_TB;
            if (wave < 4) { f32x16 d = load_T(IMG(tc), 32 * tb, 32 * vb, l31, hh);
                d = mm_tile(IMG(pc + 1), 32 * tb, IMG(tc), 32 * vb, d, l31, hh);
                store_T<M_NONE>(IMG(tn), d, 32 * tb, 32 * vb, l31, hh); }
            else if (st < NEU_STAGES - 1) {
#pragma unroll 1
                for (int q = 0; q < 2; ++q) { const int tt = 2 * w4 + q, tr = (tt >> 1) & 1, rb = (tt >> 2), cb = tt & 1;
                    const f32x16 d = mm_tile(IMG(tr ? pc : pc + 1), 32 * rb, IMG(tr ? pc + 1 : pc), 32 * cb, zero16(), l31, hh);
                    store_T<M_NONE>(IMG(pn + tr), d, 32 * rb, 32 * cb, l31, hh); } }
            WG_BAR();
        }
        if (wave < 4) { const f32x16 d = mm_tile(IMG((NEU_STAGES & 1) ? IM_TB : IM_TA), 32 * tb, IMG(IM_RHS), 32 * vb, zero16(), l31, hh); store_T<M_NONE>(IMG(IM_UT), d, 32 * tb, 32 * vb, l31, hh); }
        WG_BAR();
        if (wave >= 4) { acc_t = mm_tile(IMG(IM_AKR), 32 * tb, IMG(IM_VT), 32 * vb, acc_t, l31, hh);
            const f32x16 m = mm_tile(IMG(IM_ABR), 32 * tb, IMG(IM_UT), 32 * vb, zero16(), l31, hh);
#pragma unroll
            for (int q = 0; q < 16; ++q) YC[(32 * tb + (q & 3) + 8 * (q >> 2) + 4 * hh) * 64 + 32 * vb + l31] = acc_t[q] - m[q]; }
        else { acc_s = mm_tile(IMG(IM_KTT), 32 * tb, IMG(IM_VT), 32 * vb, acc_s, l31, hh);
            const f32x16 m = mm_tile(IMG(IM_BTT), 32 * tb, IMG(IM_UT), 32 * vb, zero16(), l31, hh);
#pragma unroll
            for (int q = 0; q < 16; ++q) acc_s[q] = (acc_s[q] - m[q]) * WLAST[32 * tb + (q & 3) + 8 * (q >> 2) + 4 * hh]; }
        WG_BAR();
        if (wave < 4) store_T<M_NONE>(IMG(IM_S0), acc_s, 32 * tb, 32 * vb, l31, hh);
        { const f32x4 y0 = *(LAS f32x4*)(YC + fi * 64 + fc), y1 = *(LAS f32x4*)(YC + fi * 64 + fc + 4);
          v4u w; w.x = cvt_pk_bf16(y0[0], y0[1]); w.y = cvt_pk_bf16(y0[2], y0[3]); w.z = cvt_pk_bf16(y1[0], y1[1]); w.w = cvt_pk_bf16(y1[2], y1[3]);
          *(GAS v4u*)(Y + (size_t)t * 512 + fc) = w; }
    }
    WG_BAR();
#undef IMG
}
__device__ __forceinline__ void p4_unit(const Args& a, const Ctx& F, int unit) {
    unsigned char* ws = a.ws; const int tid = F.tid, lane = F.lane, wave = F.wave, l31 = lane & 31, hh = lane >> 5;
    const int m0 = unit * 32, b = m0 / SEQ, s0 = m0 % SEQ;
    const bf16* Ub = (const bf16*)(ws + WS_U) + (size_t)b * SEQ * INCP;
    LAS bf16* AS = (LAS bf16*)(F.lds + RING_OFF);
    LAS float* GS = (LAS float*)(F.lds + RING_OFF + 16384);
    const float* mu = a.in[I_MU];
    for (int it = tid; it < 640; it += NTHR) { const int tok = it / 20, g = it % 20; float x[8]; mix8(Ub, s0 + tok, C_GL + 8 * g, mu, x);
#pragma unroll
        for (int j = 0; j < 8; ++j) x[j] = fast_sigmoid(x[j]);
        *(LAS v4u*)(AS + tok * 168 + 8 * g) = pack8(x); }
    LDS_WAIT(); __syncthreads();
    const bf16* G2 = (const bf16*)(ws + WS_LG2);
#pragma unroll
    for (int cc = 0; cc < 2; ++cc) { const int ct = 2 * wave + cc; f32x16 acc;
#pragma unroll
        for (int i = 0; i < 16; ++i) acc[i] = 0.f;
#pragma unroll
        for (int ks = 0; ks < 10; ++ks) { const bf16x8 af = *(const LAS bf16x8*)(AS + l31 * 168 + 16 * ks + 8 * hh); const bf16x8 bf_ = *(const GAS bf16x8*)(G2 + (size_t)(32 * ct + l31) * 192 + 16 * ks + 8 * hh); acc = MFMA32(af, bf_, acc); }
#pragma unroll
        for (int r = 0; r < 16; ++r) GS[((r & 3) + 8 * (r >> 2) + 4 * hh) * 516 + 32 * ct + l31] = acc[r]; }
    LDS_WAIT(); __syncthreads();
    { const int tok = tid >> 4, sub = tid & 15, head = sub >> 1, ch0 = head * 64 + (sub & 1) * 32, m = m0 + tok, s = s0 + tok;
      const bf16* Yf = (const bf16*)(ws + WS_Y) + (size_t)m * 512 + ch0; const bf16* Yb = Yf + (size_t)MT * 512;
      float y[32]; float sm = 0.f;
#pragma unroll
      for (int q = 0; q < 4; ++q) { float f[8], g[8]; unpack8(*(const GAS v4u*)(Yf + 8 * q), f); unpack8(*(const GAS v4u*)(Yb + 8 * q), g);
#pragma unroll
          for (int j = 0; j < 8; ++j) { y[8 * q + j] = f[j] + g[j]; sm += y[8 * q + j]; } }
      sm += dpp_f<0xB1>(sm); const float mean = sm * (1.f / 64.f); float vs = 0.f;
#pragma unroll
      for (int j = 0; j < 32; ++j) { y[j] -= mean; vs += y[j] * y[j]; }
      vs += dpp_f<0xB1>(vs); const float rstd = 1.0f / sqrtf(vs * (1.f / 64.f) + RW_LN_EPS);
      const float* BF = (const float*)(ws + WS_BON) + (size_t)m * 8 + head; const float bonus = BF[0] + BF[(size_t)MT * 8];
      const float* lg = a.in[I_LNG] + ch0; const float* lb = a.in[I_LNB] + ch0;
      bf16* dst = (bf16*)(ws + WS_MIX) + (size_t)m * DM + 512 + ch0;
#pragma unroll
      for (int q = 0; q < 4; ++q) { float v[8]; mix8(Ub, s, C_RV + ch0 + 8 * q, mu, v); float o[8];
#pragma unroll
          for (int j = 0; j < 8; ++j) { const int cix = 8 * q + j; o[j] = (y[cix] * rstd * lg[cix] + lb[cix] + bonus * v[j]) * GS[tok * 516 + ch0 + cix]; }
          *(GAS v4u*)(dst + 8 * q) = pack8(o); } }
    LDS_WAIT(); __syncthreads();
}

__device__ __forceinline__ void p6_router(const Args& a, const Ctx& F) {
    unsigned char* ws = a.ws; const int lane = F.lane;
    const int gw = F.vcu * NWAVES + F.wave, NGW = F.G * NWAVES;
    const float* gf = a.in[I_GFFN]; const float* wr = a.in[I_WR];
    LAS float* WT = (LAS float*)(F.lds + RING_OFF);
    for (int i = F.tid; i < DM * 16; i += NTHR) WT[(i & 15) * DM + (i >> 4)] = wr[i];
    LDS_WAIT(); __syncthreads();
    for (int m = gw; m < MT; m += NGW) {
        const GAS v2u* xr = (const GAS v2u*)((const bf16*)(ws + WS_HB) + (size_t)m * DM) + lane;
        f32x4 v[4]; float s = 0.f;
#pragma unroll
        for (int j = 0; j < 4; ++j) { const v2u w = xr[64 * j]; v[j][0] = bflo(w.x); v[j][1] = bfhi(w.x); v[j][2] = bflo(w.y); v[j][3] = bfhi(w.y); s += (v[j][0] * v[j][0] + v[j][1] * v[j][1]) + (v[j][2] * v[j][2] + v[j][3] * v[j][3]); }
        const float rstd = 1.0f / sqrtf(wave_sum(s) * (1.f / DM) + NORM_EPS);
        GAS unsigned* o8 = (GAS unsigned*)(ws + WS_HN8 + (size_t)m * DM) + lane;
#pragma unroll
        for (int j = 0; j < 4; ++j) { const f32x4 g = *(const f32x4*)(gf + 4 * lane + 256 * j); v[j] = v[j] * rstd * g; o8[64 * j] = pg8::cvt4_fp8(v[j][0], v[j][1], v[j][2], v[j][3]); }
        float lg[16];
        int woff = 4 * lane; asm volatile("" : "+v"(woff));
#pragma unroll
        for (int e = 0; e < 16; ++e) { float acc = 0.f;
#pragma unroll
            for (int j = 0; j < 4; ++j) { const f32x4 w = *(const LAS f32x4*)(WT + e * DM + woff + 256 * j); acc += (v[j][0] * w[0] + v[j][1] * w[1]) + (v[j][2] * w[2] + v[j][3] * w[3]); }
            lg[e] = acc; }
        float v8[8], v4[4], v2[2], v1;
        { const bool b5 = lane & 32, b4 = lane & 16, b3 = lane & 8, b2 = lane & 4;
#pragma unroll
          for (int j = 0; j < 8; ++j) { const float snd = b5 ? lg[j] : lg[8 + j], kp = b5 ? lg[8 + j] : lg[j]; v8[j] = kp + __shfl_xor(snd, 32); }
#pragma unroll
          for (int j = 0; j < 4; ++j) { const float snd = b4 ? v8[j] : v8[4 + j], kp = b4 ? v8[4 + j] : v8[j]; v4[j] = kp + __shfl_xor(snd, 16); }
#pragma unroll
          for (int j = 0; j < 2; ++j) { const float snd = b3 ? v4[j] : v4[2 + j], kp = b3 ? v4[2 + j] : v4[j]; v2[j] = kp + __shfl_xor(snd, 8); }
          { const float snd = b2 ? v2[0] : v2[1], kp = b2 ? v2[1] : v2[0]; v1 = kp + __shfl_xor(snd, 4); }
          v1 += __shfl_xor(v1, 2); v1 += __shfl_xor(v1, 1); }
        float mx = v1;
        mx = fmaxf(mx, __shfl_xor(mx, 32)); mx = fmaxf(mx, __shfl_xor(mx, 16)); mx = fmaxf(mx, __shfl_xor(mx, 8)); mx = fmaxf(mx, __shfl_xor(mx, 4));
        const float ex = fexp2((v1 - mx) * LOG2E);
        float den = ex; den += __shfl_xor(den, 32); den += __shfl_xor(den, 16); den += __shfl_xor(den, 8); den += __shfl_xor(den, 4);
        if ((lane & 3) == 0) ((float*)(ws + WS_AFF))[((size_t)(m / SEQ) * 16 + (lane >> 2)) * SEQ + (m % SEQ)] = ex / den;
        const bf16* pe = (const bf16*)(ws + WS_PE) + (size_t)m * DM + lane * 8; float ps = 0.f;
#pragma unroll
        for (int j = 0; j < 2; ++j) { float t[8]; unpack8(*(const GAS v4u*)(pe + 512 * j), t);
#pragma unroll
            for (int i = 0; i < 8; ++i) ps += t[i] * t[i]; }
        ps = wave_sum(ps);
        if (lane == 0) ((float*)(ws + WS_PERS))[m] = 1.0f / sqrtf(ps * (1.f / DM) + NORM_EPS);
    }
    LDS_WAIT(); __syncthreads();
}

__device__ __forceinline__ void p7_topk_unit(const Args& a, const Ctx& F, int unit) {
    unsigned char* ws = a.ws; const int tid = F.tid, lane = F.lane, wave = F.wave;
    const int b = unit >> 4, e = unit & 15;
    LAS unsigned* hist = (LAS unsigned*)(F.lds + RING_OFF);
    LAS unsigned* ctl = hist + 256;
    LAS unsigned* wtot = hist + 320;
    const float* aff = (const float*)(ws + WS_AFF) + ((size_t)b * 16 + e) * SEQ;
    const f32x4 av = *(const GAS f32x4*)(aff + 4 * tid);
    unsigned key[4];
#pragma unroll
    for (int j = 0; j < 4; ++j) key[j] = __float_as_uint(av[j]);
    unsigned prefix = 0u, mask = 0u, krem = CAP;
#pragma unroll 1
    for (int pass = 3; pass >= 0; --pass) { const int sh = 8 * pass;
        if (tid < 256) hist[tid] = 0u;
        LDS_WAIT(); __syncthreads();
#pragma unroll
        for (int j = 0; j < 4; ++j) if ((key[j] & mask) == prefix) atomicAdd((unsigned*)&hist[(key[j] >> sh) & 255u], 1u);
        LDS_WAIT(); __syncthreads();
        if (wave == 0) {
            const unsigned h0 = hist[4 * lane], h1 = hist[4 * lane + 1], h2 = hist[4 * lane + 2], h3 = hist[4 * lane + 3];
            const unsigned tot = h0 + h1 + h2 + h3; unsigned suf = tot;
#pragma unroll
            for (int o = 1; o < 64; o <<= 1) { const unsigned t = __shfl_down(suf, o); if (lane + o < 64) suf += t; }
            const unsigned above = suf - tot;
            const unsigned g3 = above, g2 = above + h3, g1 = g2 + h2, g0 = g1 + h1;
            if (g3 < krem && krem <= g3 + h3) { ctl[0] = 4 * lane + 3; ctl[1] = krem - g3; }
            else if (g2 < krem && krem <= g2 + h2) { ctl[0] = 4 * lane + 2; ctl[1] = krem - g2; }
            else if (g1 < krem && krem <= g1 + h1) { ctl[0] = 4 * lane + 1; ctl[1] = krem - g1; }
            else if (g0 < krem && krem <= g0 + h0) { ctl[0] = 4 * lane + 0; ctl[1] = krem - g0; }
        }
        LDS_WAIT(); __syncthreads();
        prefix |= ctl[0] << sh; mask |= 255u << sh; krem = ctl[1];
        LDS_WAIT(); __syncthreads();
    }
    unsigned ngt = 0, neq = 0;
#pragma unroll
    for (int j = 0; j < 4; ++j) { ngt += key[j] > prefix; neq += key[j] == prefix; }
    unsigned pk = ngt | (neq << 16), inc = pk;
#pragma unroll
    for (int o = 1; o < 64; o <<= 1) { const unsigned t = __shfl_up(inc, o); if (lane >= o) inc += t; }
    if (lane == 63) wtot[wave] = inc;
    LDS_WAIT(); __syncthreads();
    unsigned base = 0, total = 0;
#pragma unroll
    for (int w = 0; w < 8; ++w) { const unsigned t = wtot[w]; if (w < wave) base += t; total += t; }
    unsigned ex = base + inc - pk; unsigned gpre = ex & 0xffffu, epre = ex >> 16; const unsigned cgt = total & 0xffffu;
    int* SEL = (int*)(ws + WS_SEL) + ((size_t)b * SEQ + 4 * tid) * 16 + e;
    int* RM = (int*)(ws + WS_RMAP) + ((size_t)e * NB + b) * CAP;
    float* GT = (float*)(ws + WS_GATE) + ((size_t)e * NB + b) * CAP;
#pragma unroll
    for (int j = 0; j < 4; ++j) { int slot = -1;
        if (key[j] > prefix) { slot = (int)gpre; ++gpre; }
        else if (key[j] == prefix) { if (epre < krem) slot = (int)(cgt + epre); ++epre; }
        SEL[j * 16] = slot;
        if (slot >= 0) { RM[slot] = b * SEQ + 4 * tid + j; GT[slot] = av[j]; } }
    LDS_WAIT(); __syncthreads();
}
__device__ __forceinline__ void moe_combine(const Args& a, const Ctx& F) {
    unsigned char* ws = a.ws; const int lane = F.lane;
    const int gw = F.vcu * NWAVES + F.wave, NGW = F.G * NWAVES;
    const int* SEL = (const int*)(ws + WS_SEL);
    for (int m = gw; m < MT; m += NGW) { const int b = m / SEQ;
        const int sl = SEL[(size_t)m * 16 + (lane & 15)];
        const GAS v2u* hr = (const GAS v2u*)((const bf16*)(ws + WS_HB) + (size_t)m * DM) + lane;
        f32x4 v[4];
#pragma unroll
        for (int j = 0; j < 4; ++j) { const v2u w = hr[64 * j]; v[j][0] = bflo(w.x); v[j][1] = bfhi(w.x); v[j][2] = bflo(w.y); v[j][3] = bfhi(w.y); }
#pragma unroll 1
        for (int e = 0; e < NE; ++e) { const int slot = __builtin_amdgcn_readlane(sl, e);
            if (slot >= 0) { const GAS v2u* yr = (const GAS v2u*)((const bf16*)(ws + WS_YE) + (size_t)((e * NB + b) * CAP + slot) * DM) + lane;
#pragma unroll
                for (int j = 0; j < 4; ++j) { const v2u w = yr[64 * j]; v[j][0] += bflo(w.x); v[j][1] += bfhi(w.x); v[j][2] += bflo(w.y); v[j][3] += bfhi(w.y); } } }
        GAS v2u* h2r = (GAS v2u*)((bf16*)(ws + WS_H2B) + (size_t)m * DM) + lane;
#pragma unroll
        for (int j = 0; j < 4; ++j) { v2u w; w.x = cvt_pk_bf16(v[j][0], v[j][1]); w.y = cvt_pk_bf16(v[j][2], v[j][3]); h2r[64 * j] = w; }
        float s = 0.f;
#pragma unroll
        for (int j = 0; j < 4; ++j) s += (v[j][0] * v[j][0] + v[j][1] * v[j][1]) + (v[j][2] * v[j][2] + v[j][3] * v[j][3]);
        const float rstd = 1.0f / sqrtf(wave_sum(s) * (1.f / DM) + NORM_EPS); const float* gp = a.in[I_GPLE];
        GAS unsigned* o8 = (GAS unsigned*)(ws + WS_HN2 + (size_t)m * DM) + lane;
#pragma unroll
        for (int j = 0; j < 4; ++j) { const f32x4 g4 = *(const f32x4*)(gp + 4 * lane + 256 * j); o8[64 * j] = pg8::cvt4_fp8(v[j][0] * rstd * g4[0], v[j][1] * rstd * g4[1], v[j][2] * rstd * g4[2], v[j][3] * rstd * g4[3]); }
    }
}
#ifndef PEEL_P1
#define PEEL_P1 true
#endif
#ifndef PEEL_G1
#define PEEL_G1 true
#endif
#ifndef PEEL_G2
#define PEEL_G2 true
#endif
#ifndef PEEL_FIN
#define PEEL_FIN true
#endif
constexpr int NPHASE = 10;
__global__ void __launch_bounds__(NTHR, 2) fwd_kernel(Args args) {
    extern __shared__ __attribute__((aligned(16))) unsigned char lds[];
    Ctx F; F.lds = (LAS unsigned char*)lds; F.tid = threadIdx.x; F.lane = F.tid & 63; F.wave = __builtin_amdgcn_readfirstlane(F.tid >> 6);
    F.G = gridDim.x; { const int bx = blockIdx.x; F.vcu = (F.G % 8 == 0) ? (bx % 8) * (F.G / 8) + bx / 8 : bx; }
    unsigned char* ws = args.ws;
    for (int u = F.tid; u < (LDS_BYTES - LDSCTL_OFF) / 4; u += NTHR) ((LAS unsigned*)(F.lds + LDSCTL_OFF))[u] = 0u;
    __syncthreads();
    const int lo = args.ph_lo, hi = args.ph_hi;
    XcdBarrier bar; bar.bar = (unsigned*)(ws + WS_CTL) + CW_BAR + args.li * XCD_BAR_WORDS; bar.x = 0; bar.st = nullptr;
    if (hi - lo > 1) bar = xcd_barrier_post((unsigned*)(ws + WS_CTL) + CW_BAR + args.li * XCD_BAR_WORDS, (volatile LAS unsigned*)(F.lds + MISC_OFF) + 8);
#define IN(k) (lo <= (k) && (k) < hi)
#define SEAM(k) do { if (IN(k) && IN((k) + 1)) xcd_barrier(bar); } while (0)
    LAS unsigned char* ring = F.lds + RING_OFF;
    const int cblk = (int)blockIdx.x;

    if (IN(0)) { p0_prologue(args, F); SEAM(0); }

    if (IN(1)) {
        pg8::Gemm g{(const bf16*)(ws + WS_XN), (const bf16*)(ws + WS_WIN), MT, INCP, DM, 1 << 20, 0}; pg8::StaticOrder S; S.init(MT, INCP, F.G, cblk);
        pg8::EpiBf16Plain E{(bf16*)(ws + WS_U), INCP};
        pg8::gemm_phase<pg8::EpiBf16Plain, pg8::StaticOrder, true, true, false, false, PEEL_P1>(ring, g, S, E);
        SEAM(1);
    }
    if (IN(2)) {
        p2_attn_prep(args, F);
        for (int u = F.vcu; u < 2 * NB * 8; u += F.G) p3_scan_unit_chunked(args, F, u);
        SEAM(2);
    }
    if (IN(3)) {
        float lam;
        { const float p1 = (F.lane < 64) ? args.in[I_LQ1][F.lane] * args.in[I_LK1][F.lane] : 0.f, p2 = args.in[I_LQ2][F.lane] * args.in[I_LK2][F.lane];
          lam = __expf(wave_sum(p1)) - __expf(wave_sum(p2)) + 0.2f; }
        for (int u = F.vcu; u < NB * 4 * 16; u += F.G) p3_attn_unit(args, F, u, lam);
        for (int u = F.vcu; u < MT / 32; u += F.G) p4_unit(args, F, u);
        SEAM(3);
    }
    if (IN(4)) {
        { pg8::Gemm g{(const bf16*)(ws + WS_MIX), (const bf16*)(ws + WS_WOUT), MT, DM, DM, 1 << 20, 0}; pg8::StaticOrder S; S.init(MT, DM, F.G, cblk);
          pg8::EpiResBf16 E{args.in[I_X], (bf16*)(ws + WS_HB), DM};
          pg8::gemm_phase<pg8::EpiResBf16, pg8::StaticOrder, true, true>(ring, g, S, E); }
        { pg8::Gemm g{(const bf16*)(ws + WS_PB), (const bf16*)(ws + WS_WPLE), MT, DM, 256, 1 << 20, 0}; pg8::StaticOrder S; S.init(MT, DM, F.G, cblk);
          pg8::EpiBf16Plain E{(bf16*)(ws + WS_PE), DM};
          pg8::gemm_phase<pg8::EpiBf16Plain, pg8::StaticOrder, true, true>(ring, g, S, E); }
        p5_expert_weights(args, F);
        SEAM(4);
    }
    if (IN(5)) { p6_router(args, F); SEAM(5); }
    if (IN(6)) { for (int u = F.vcu; u < NB * NE; u += F.G) p7_topk_unit(args, F, u); SEAM(6); }
#define MOE_G1(gi) { pg8::Gemm g{(const bf16*)(ws + WS_HN8), (const bf16*)(ws + WS_W13 + (size_t)(gi) * EPG * 4096 * DM), MG, 4096, DM / 2, NB, (size_t)4096 * DM, (const int*)(ws + WS_RMAP) + (size_t)(gi) * MG, TAB_OFF, WSCALE_E8M0}; \
        pg8::StaticOrder S; S.init(MG, 4096, F.G, cblk); pg8::EpiSwiGLU8 E{ws + WS_HDN + (size_t)(gi) * MG * DFF, DFF}; \
        pg8::gemm_phase<pg8::EpiSwiGLU8, pg8::StaticOrder, true, true, true, true, PEEL_G1>(ring, g, S, E); }
#define MOE_G2(gi) { pg8::Gemm g{(const bf16*)(ws + WS_HDN + (size_t)(gi) * MG * DFF), (const bf16*)(ws + WS_W2T + (size_t)(gi) * EPG * DM * DFF), MG, DM, DFF / 2, NB, (size_t)DM * DFF, nullptr, 0, WSCALE_E8M0}; \
        pg8::StaticOrder S; S.init(MG, DM, F.G, cblk); pg8::EpiRowScaleBf16 E{(bf16*)(ws + WS_YE) + (size_t)(gi) * MG * DM, DM, (const float*)(ws + WS_GATE) + (size_t)(gi) * MG}; \
        pg8::gemm_phase<pg8::EpiRowScaleBf16, pg8::StaticOrder, true, true, false, true, PEEL_G2>(ring, g, S, E); }
    if (IN(7)) { MOE_G1(0) MOE_G1(1) SEAM(7); }
    if (IN(8)) { MOE_G2(0) MOE_G2(1) SEAM(8); }
#undef MOE_G1
#undef MOE_G2
    if (IN(9)) { moe_combine(args, F); SEAM(9); }
    if (IN(10)) {
        pg8::Gemm g{(const bf16*)(ws + WS_HN2), (const bf16*)(ws + WS_WPG), MT, DM, DM / 2, 1 << 20, 0, nullptr, 0, WSCALE_E8M0}; pg8::StaticOrder S; S.init(MT, DM, F.G, cblk);
        pg8::EpiPleFinal E{(const bf16*)(ws + WS_H2B), args.out, DM, (const bf16*)(ws + WS_PE), (const float*)(ws + WS_PERS), args.in[I_GPOST]};
        pg8::gemm_phase<pg8::EpiPleFinal, pg8::StaticOrder, true, true, false, true, PEEL_FIN>(ring, g, S, E);
    }
#undef IN
#undef SEAM
}

#ifndef MK_PER_PHASE
#define MK_PER_PHASE 0
#endif
extern "C" void kernel_launch(void* const* d_in, const int* in_sizes, int n_in, void* d_out, int out_size, void* d_ws, size_t ws_size, hipStream_t stream) {
    static int grid = 0;
    if (grid == 0) {
        if (n_in != N_IN || in_sizes[0] != MT * DM || out_size != MT * DM || ws_size < WS_END) { fprintf(stderr, "kernel_launch: unexpected problem (n_in %d, in0 %d, out %d, ws %zu < %zu): nothing launched\n", n_in, n_in > 0 ? in_sizes[0] : -1, out_size, ws_size, (size_t)WS_END); grid = -1; return; }
        int dev = 0, cus = 0, per_cu = 0;
        if (hipGetDevice(&dev) != hipSuccess || hipDeviceGetAttribute(&cus, hipDeviceAttributeMultiprocessorCount, dev) != hipSuccess) { grid = -1; return; }
        if (hipFuncSetAttribute((const void*)fwd_kernel, hipFuncAttributeMaxDynamicSharedMemorySize, LDS_BYTES) != hipSuccess) { fprintf(stderr, "kernel_launch: hipFuncSetAttribute failed\n"); grid = -1; return; }
        if (hipOccupancyMaxActiveBlocksPerMultiprocessor(&per_cu, (const void*)fwd_kernel, NTHR, LDS_BYTES) != hipSuccess || per_cu < 1) { fprintf(stderr, "kernel_launch: occupancy query says %d blocks per CU\n", per_cu); }
        (void)hipGetLastError();
        grid = cus;
    }
    if (grid < 0) return;
    if (hipMemsetAsync((char*)d_ws + WS_CTL, 0, CTL_ZERO_BYTES, stream) != hipSuccess) return;
    Args a{};
    for (int i = 0; i < N_IN; ++i) a.in[i] = (const float*)d_in[i];
    a.out = (float*)d_out; a.ws = (unsigned char*)d_ws; a.pad = 0;
#if MK_PER_PHASE
    for (int p = 0; p <= NPHASE; ++p) { a.ph_lo = p; a.ph_hi = p + 1; a.li = 0; hipLaunchKernelGGL(fwd_kernel, dim3(grid), dim3(NTHR), LDS_BYTES, stream, a); }
#else
    a.ph_lo = 0; a.ph_hi = NPHASE + 1; a.li = 0;
    hipLaunchKernelGGL(fwd_kernel, dim3(grid), dim3(NTHR), LDS_BYTES, stream, a);
#endif
}
```

```cpp
#include <hip/hip_runtime.h>
#include <cstdio>
#include <cstdint>
namespace pg8 {
#define PG8_LAS __attribute__((address_space(3)))
typedef unsigned short bf16_t;
typedef short bf16x8 __attribute__((ext_vector_type(8)));
typedef float f32x4 __attribute__((ext_vector_type(4)));
typedef float f32x2 __attribute__((ext_vector_type(2)));
typedef unsigned u32x4 __attribute__((ext_vector_type(4)));
typedef unsigned u32x2 __attribute__((ext_vector_type(2)));
typedef __bf16 bf16x2_t __attribute__((ext_vector_type(2)));
typedef int v4i __attribute__((ext_vector_type(4)));
typedef int v8i __attribute__((ext_vector_type(8)));
constexpr int BM = 256, BK = 64, HALF = 128, HTB = HALF * BK * 2, STAGE_BYTES = 8 * HTB, NXCD = 8, WGM = 8;

__host__ __device__ __forceinline__ int lds_byte(int r, int c) { const int st = (r >> 4) * 2 + (c >> 5), rr = r & 15, cc = c & 31, ob = rr * 64 + cc * 2; return st * 1024 + (ob ^ (((ob >> 9) & 1) << 5)); }
__host__ __device__ __forceinline__ void stage_rc(int b, int& R, int& C) { const int st = b / 1024, sb = b % 1024, swz = sb ^ (((sb >> 9) & 1) << 5); R = (st >> 1) * 16 + swz / 64; C = (st & 1) * 32 + (swz % 64) / 2; }
__host__ __device__ __forceinline__ int perm32(int rho) { const int n = rho >> 4, i = rho & 15; return 8 * (i >> 2) + 4 * n + (i & 3); }

struct Unit { int pm, pn; };
struct Gemm { const bf16_t* A; const bf16_t* Bt; int M, N, K; int tpg; size_t gstride; const int* arow = nullptr; int tab_off = 0; int wscale = 0x7f7f7f7f; int wid = 0; };

struct StaticOrder {
    int nM, nN, nwg, G, c, i0, iN;
    __host__ __device__ void init(int M, int N, int G_, int c_) { nM = M / BM; nN = N / BM; nwg = nM * nN; G = G_; c = c_; i0 = 0; iN = 1 << 20; }
    __host__ __device__ bool next(int i, Unit& u) const {
        i += i0; if (i >= iN) return false;
        const long L = (long)i * G + c; if (L >= nwg) return false;
        int wgid = (int)L; { const int q = nwg / NXCD, r = nwg % NXCD, xcd = wgid % NXCD, off = wgid / NXCD; wgid = (xcd < r ? xcd * (q + 1) : r * (q + 1) + (xcd - r) * q) + off; }
        const int nig = WGM * nN, gid = wgid / nig, fm = gid * WGM, gsz = (nM - fm) < WGM ? (nM - fm) : WGM;
        u.pm = fm + ((wgid % nig) % gsz); u.pn = (wgid % nig) / gsz; return true;
    }
    __device__ __forceinline__ void a_ready(const Unit&) const {}
    __device__ __forceinline__ void done(const Unit&) const {}
};

__device__ __forceinline__ unsigned cvt_pk_bf16(float lo, float hi) { f32x2 v = {lo, hi}; bf16x2_t b = __builtin_convertvector(v, bf16x2_t); return __builtin_bit_cast(unsigned, b); }
__device__ __forceinline__ float fast_sigmoid(float x) { return __builtin_amdgcn_rcpf(1.0f + __builtin_amdgcn_exp2f(-1.4426950408889634f * x)); }

struct EpiBf16Plain {
    static constexpr bool PERM = true, AFTER_DRAIN = false;
    bf16_t* O; int ldc;
    __device__ __forceinline__ void operator()(const f32x4 (&acc)[2][2][4][2], const Unit& u, int wr, int wc, int fr, int fq) const {
        const int row0 = u.pm * BM + wr * 64 + fr, col0 = u.pn * BM + wc * 32 + 8 * fq;
#pragma unroll
        for (int ai = 0; ai < 2; ++ai)
#pragma unroll
            for (int m = 0; m < 4; ++m) { bf16_t* rowp = O + (size_t)(row0 + ai * HALF + m * 16) * ldc + col0;
#pragma unroll
                for (int bj = 0; bj < 2; ++bj) { const f32x4 v0 = acc[ai][bj][m][0], v1 = acc[ai][bj][m][1];
                    u32x4 w; w.x = cvt_pk_bf16(v0[0], v0[1]); w.y = cvt_pk_bf16(v0[2], v0[3]); w.z = cvt_pk_bf16(v1[0], v1[1]); w.w = cvt_pk_bf16(v1[2], v1[3]);
                    *(u32x4*)(rowp + bj * HALF) = w; } }
    }
};
struct EpiSwiGLU {
    static constexpr bool PERM = true, AFTER_DRAIN = false;
    bf16_t* O; int ldc;
    __device__ __forceinline__ void operator()(const f32x4 (&acc)[2][2][4][2], const Unit& u, int wr, int wc, int fr, int fq) const {
        const int row0 = u.pm * BM + wr * 64 + fr, col0 = u.pn * HALF + wc * 32 + 8 * fq;
#pragma unroll
        for (int ai = 0; ai < 2; ++ai)
#pragma unroll
            for (int m = 0; m < 4; ++m) { bf16_t* rowp = O + (size_t)(row0 + ai * HALF + m * 16) * ldc + col0;
                float r[8];
#pragma unroll
                for (int n = 0; n < 2; ++n)
#pragma unroll
                    for (int j = 0; j < 4; ++j) { const float a = acc[ai][0][m][n][j], b = acc[ai][1][m][n][j]; r[4 * n + j] = a * fast_sigmoid(a) * b; }
                u32x4 w; w.x = cvt_pk_bf16(r[0], r[1]); w.y = cvt_pk_bf16(r[2], r[3]); w.z = cvt_pk_bf16(r[4], r[5]); w.w = cvt_pk_bf16(r[6], r[7]);
                *(u32x4*)rowp = w; }
    }
};
__device__ __forceinline__ unsigned cvt4_fp8(float a, float b, float c, float d) { int w = 0; w = __builtin_amdgcn_cvt_pk_fp8_f32(a, b, w, false); w = __builtin_amdgcn_cvt_pk_fp8_f32(c, d, w, true); return (unsigned)w; }
struct EpiSwiGLU8 {
    static constexpr bool PERM = true, AFTER_DRAIN = false;
    unsigned char* O; int ldc;
    __device__ __forceinline__ void operator()(const f32x4 (&acc)[2][2][4][2], const Unit& u, int wr, int wc, int fr, int fq) const {
        const int row0 = u.pm * BM + wr * 64 + fr, col0 = u.pn * HALF + wc * 32 + 8 * fq;
#pragma unroll
        for (int ai = 0; ai < 2; ++ai)
#pragma unroll
            for (int m = 0; m < 4; ++m) { unsigned char* rowp = O + (size_t)(row0 + ai * HALF + m * 16) * ldc + col0;
                float r[8];
#pragma unroll
                for (int n = 0; n < 2; ++n)
#pragma unroll
                    for (int j = 0; j < 4; j += 2) {
                        const f32x2 a2 = {acc[ai][0][m][n][j], acc[ai][0][m][n][j + 1]}, b2 = {acc[ai][1][m][n][j], acc[ai][1][m][n][j + 1]};
                        const f32x2 t = a2 * (f32x2){-1.4426950408889634f, -1.4426950408889634f};
                        const f32x2 d = (f32x2){__builtin_amdgcn_exp2f(t[0]), __builtin_amdgcn_exp2f(t[1])} + (f32x2){1.0f, 1.0f};
                        const f32x2 q = (a2 * b2) * (f32x2){__builtin_amdgcn_rcpf(d[0]), __builtin_amdgcn_rcpf(d[1])};
                        r[4 * n + j] = q[0]; r[4 * n + j + 1] = q[1]; }
                u32x2 w; w.x = cvt4_fp8(r[0], r[1], r[2], r[3]); w.y = cvt4_fp8(r[4], r[5], r[6], r[7]);
                *(u32x2*)rowp = w; }
    }
};
struct EpiRowScaleBf16 {
    static constexpr bool PERM = true, AFTER_DRAIN = false;
    bf16_t* O; int ldc; const float* scale;
    __device__ __forceinline__ void operator()(const f32x4 (&acc)[2][2][4][2], const Unit& u, int wr, int wc, int fr, int fq) const {
        const int row0 = u.pm * BM + wr * 64 + fr, col0 = u.pn * BM + wc * 32 + 8 * fq;
#pragma unroll
        for (int ai = 0; ai < 2; ++ai)
#pragma unroll
            for (int m = 0; m < 4; ++m) { const int row = row0 + ai * HALF + m * 16; const float sc = scale[row]; bf16_t* rowp = O + (size_t)row * ldc + col0;
#pragma unroll
                for (int bj = 0; bj < 2; ++bj) { const f32x4 v0 = acc[ai][bj][m][0] * sc, v1 = acc[ai][bj][m][1] * sc;
                    u32x4 w; w.x = cvt_pk_bf16(v0[0], v0[1]); w.y = cvt_pk_bf16(v0[2], v0[3]); w.z = cvt_pk_bf16(v1[0], v1[1]); w.w = cvt_pk_bf16(v1[2], v1[3]);
                    *(u32x4*)(rowp + bj * HALF) = w; } }
    }
};
struct EpiResF32 {
    static constexpr bool PERM = false, AFTER_DRAIN = false;
    const float* base; float* out; int ldc;
    __device__ __forceinline__ void operator()(const f32x4 (&acc)[2][2][4][2], const Unit& u, int wr, int wc, int fr, int fq) const {
        const int row0 = u.pm * BM + wr * 64 + fr, col0 = u.pn * BM + wc * 32 + 4 * fq;
#pragma unroll
        for (int ai = 0; ai < 2; ++ai)
#pragma unroll
            for (int m = 0; m < 4; ++m) { const size_t off = (size_t)(row0 + ai * HALF + m * 16) * ldc + col0;
#pragma unroll
                for (int bj = 0; bj < 2; ++bj)
#pragma unroll
                    for (int n = 0; n < 2; ++n) { const f32x4 bs = *(const f32x4*)(base + off + bj * HALF + n * 16); *(f32x4*)(out + off + bj * HALF + n * 16) = bs + acc[ai][bj][m][n]; } }
    }
};
struct EpiResBf16 {
    static constexpr bool PERM = false, AFTER_DRAIN = false;
    const float* base; bf16_t* out; int ldc;
    __device__ __forceinline__ void operator()(const f32x4 (&acc)[2][2][4][2], const Unit& u, int wr, int wc, int fr, int fq) const {
        const int row0 = u.pm * BM + wr * 64 + fr, col0 = u.pn * BM + wc * 32 + 4 * fq;
#pragma unroll
        for (int ai = 0; ai < 2; ++ai)
#pragma unroll
            for (int m = 0; m < 4; ++m) { const size_t off = (size_t)(row0 + ai * HALF + m * 16) * ldc + col0;
#pragma unroll
                for (int bj = 0; bj < 2; ++bj)
#pragma unroll
                    for (int n = 0; n < 2; ++n) { const f32x4 v = *(const f32x4*)(base + off + bj * HALF + n * 16) + acc[ai][bj][m][n];
                        u32x2 w; w.x = cvt_pk_bf16(v[0], v[1]); w.y = cvt_pk_bf16(v[2], v[3]); *(u32x2*)(out + off + bj * HALF + n * 16) = w; } }
    }
};
struct EpiPleFinal {
    static constexpr bool PERM = false, AFTER_DRAIN = false;
    const bf16_t* h2; float* out; int ldc; const bf16_t* pe; const float* prs; const float* gp;
#ifdef TPROBE
    float dbg;
#endif
    __device__ __forceinline__ void operator()(const f32x4 (&acc)[2][2][4][2], const Unit& u, int wr, int wc, int fr, int fq) const {
        const int row0 = u.pm * BM + wr * 64 + fr, col0 = u.pn * BM + wc * 32 + 4 * fq;
        f32x4 g4[2][2];
#pragma unroll
        for (int bj = 0; bj < 2; ++bj)
#pragma unroll
            for (int n = 0; n < 2; ++n) g4[bj][n] = *(const f32x4*)(gp + col0 + bj * HALF + n * 16);
#pragma unroll
        for (int ai = 0; ai < 2; ++ai)
#pragma unroll
            for (int m = 0; m < 4; ++m) { const int row = row0 + ai * HALF + m * 16; const size_t off = (size_t)row * ldc + col0; const float rs = prs[row];
#pragma unroll
                for (int bj = 0; bj < 2; ++bj)
#pragma unroll
                    for (int n = 0; n < 2; ++n) { const size_t o2 = off + bj * HALF + n * 16; const u32x2 hw = *(const u32x2*)(h2 + o2); const u32x2 pw = *(const u32x2*)(pe + o2);
                        f32x4 hv, e; hv[0] = __uint_as_float(hw.x << 16); hv[1] = __uint_as_float(hw.x & 0xffff0000u); hv[2] = __uint_as_float(hw.y << 16); hv[3] = __uint_as_float(hw.y & 0xffff0000u);
                        e[0] = __uint_as_float(pw.x << 16); e[1] = __uint_as_float(pw.x & 0xffff0000u); e[2] = __uint_as_float(pw.y << 16); e[3] = __uint_as_float(pw.y & 0xffff0000u);
                        const f32x4 a = acc[ai][bj][m][n]; f32x4 o;
#pragma unroll
                        for (int j = 0; j < 4; ++j) o[j] = hv[j] + fast_sigmoid(a[j]) * (e[j] * rs * g4[bj][n][j]);
#ifdef TPROBE
                        o *= dbg;
#endif
                        *(f32x4*)(out + o2) = o; } }
    }
};
template <class Epi, class Sched, bool ALIGN_EPI = false, bool SP2 = false, bool GATHER = false, bool FP8 = false>
__device__ __forceinline__ void gemm_phase(PG8_LAS unsigned char* lds, const Gemm g, const Sched& S, const Epi& E) {
    int lane_; asm volatile("v_mbcnt_lo_u32_b32 %0, -1, 0\n\tv_mbcnt_hi_u32_b32 %0, -1, %0" : "=v"(lane_));
    const int wid = g.wid, lane = lane_, tid = wid * 64 + lane, wr = wid >> 2, wc = wid & 3, fr = lane & 15, fq = lane >> 4;
    const int K = g.K, nt = K / BK;
    unsigned voffA[2], voffB[2];
#pragma unroll
    for (int i = 0; i < 2; ++i) { int R, C; stage_rc(tid * 16 + i * 8192, R, C); const int Rb = Epi::PERM ? ((R & ~31) + perm32(R & 31)) : R;
        voffA[i] = (unsigned)(R * K + C) * 2u; voffB[i] = (unsigned)(Rb * K + C) * 2u; }
    static_assert(!GATHER || SP2, "gathered A rows: SP2 loop only");
    int gR[2], gC[2];
#pragma unroll
    for (int i = 0; i < 2; ++i) stage_rc(tid * 16 + i * 8192, gR[i], gC[i]);
    unsigned vAc[2][2], vAn[2][2], vS[2][2];
#pragma unroll
    for (int hf = 0; hf < 2; ++hf)
#pragma unroll
        for (int i = 0; i < 2; ++i) { vAc[hf][i] = 0u; vAn[hf][i] = 0u; vS[hf][i] = 0u; }
    const size_t kstep = (size_t)(BK * 2);
    const size_t hstep = (size_t)HALF * K * 2;
    const size_t hstepA = GATHER ? 0 : hstep;
    const size_t tstep = 2 * hstep;
    const unsigned ldsw = (unsigned)wid * 1024u;
    const int aoff = FP8 ? lds_byte(wr * 64 + fr, 16 * (fq & 1)) + (fq >> 1) * 1024 : lds_byte(wr * 64 + fr, fq * 8);
    const int boff = FP8 ? lds_byte(wc * 32 + fr, 16 * (fq & 1)) + (fq >> 1) * 1024 : lds_byte(wc * 32 + fr, fq * 8);

#define PG8_SA(b, h) (((b) * 2 + (h)) * HTB)
#define PG8_SB(b, h) ((4 + (b) * 2 + (h)) * HTB)
#define PG8_STAGE(bufoff, gbase, voff) do { _Pragma("unroll") for (int _i = 0; _i < 2; ++_i) \
        __builtin_amdgcn_global_load_lds((const unsigned*)((const char*)(gbase) + (voff)[_i]), (PG8_LAS unsigned*)(lds + (bufoff) + ldsw + _i * 8192), 16, 0, 0); } while (0)
#define PG8_LD8(p_) __builtin_shufflevector(*(const PG8_LAS v4i*)(p_), *(const PG8_LAS v4i*)((p_) + 16), 0, 1, 2, 3, 4, 5, 6, 7)
#define PG8_LDA(dst, b, h) do { if constexpr (FP8) { _Pragma("unroll") for (int m = 0; m < 4; ++m) dst##8[m] = PG8_LD8(lds + PG8_SA(b, h) + aoff + m * 2048); } \
        else { _Pragma("unroll") for (int m = 0; m < 4; ++m) _Pragma("unroll") for (int k = 0; k < 2; ++k) dst[m][k] = *(const PG8_LAS bf16x8*)(lds + PG8_SA(b, h) + aoff + m * 2048 + k * 1024); } } while (0)
#define PG8_LDB(dst, b, h) do { if constexpr (FP8) { _Pragma("unroll") for (int n = 0; n < 2; ++n) dst##8[n] = PG8_LD8(lds + PG8_SB(b, h) + boff + n * 2048); } \
        else { _Pragma("unroll") for (int n = 0; n < 2; ++n) _Pragma("unroll") for (int k = 0; k < 2; ++k) dst[n][k] = *(const PG8_LAS bf16x8*)(lds + PG8_SB(b, h) + boff + n * 2048 + k * 1024); } } while (0)
#define PG8_MMA(ai, bj, At, Bt) do { __builtin_amdgcn_s_setprio(1); _Pragma("unroll") for (int m = 0; m < 4; ++m) _Pragma("unroll") for (int n = 0; n < 2; ++n) { \
        if constexpr (FP8) asm volatile("s_nop 1\n\tv_mfma_scale_f32_16x16x128_f8f6f4 %0, %1, %2, %0, %3, %4 op_sel_hi:[0,0,0]" : "+v"(acc[ai][bj][m][n]) : "v"(Bt##8[n]), "v"(At##8[m]), "v"(wsc_), "v"(asc_));     \
        else { _Pragma("unroll") for (int k = 0; k < 2; ++k) acc[ai][bj][m][n] = __builtin_amdgcn_mfma_f32_16x16x32_bf16(Bt[n][k], At[m][k], acc[ai][bj][m][n], 0, 0, 0); } } \
        __builtin_amdgcn_s_setprio(0); } while (0)
#define PG8_WAIT_V(n) asm volatile("s_waitcnt vmcnt(" #n ")" ::: "memory")
#define PG8_WAIT_L(n) asm volatile("s_waitcnt lgkmcnt(" #n ")" ::: "memory")
#define PG8_BAR __builtin_amdgcn_s_barrier()
#define PG8_SCHED __builtin_amdgcn_sched_barrier(0)
    Unit cur, nxt; int ui = 0;
    if (!S.next(0, cur)) return;
    f32x4 acc[2][2][4][2];
#pragma unroll
    for (int a = 0; a < 2; ++a)
#pragma unroll
        for (int b = 0; b < 2; ++b)
#pragma unroll
            for (int m = 0; m < 4; ++m)
#pragma unroll
                for (int n = 0; n < 2; ++n) acc[a][b][m][n] = (f32x4){0.f, 0.f, 0.f, 0.f};
    int wsc_ = g.wscale, asc_ = 0x7f7f7f7f; asm volatile("" : "+v"(wsc_), "+v"(asc_));
    bf16x8 At[4][2], B0[2][2], B1[2][2]; v8i At8[4], B08[2], B18[2];
    if constexpr (GATHER) {
        PG8_LAS int* tab = (PG8_LAS int*)(lds + g.tab_off); Unit uu;
        for (int i = 0; S.next(i, uu); ++i) for (int r = tid; r < BM; r += 512) tab[i * BM + r] = g.arow[(size_t)uu.pm * BM + r];
        asm volatile("s_waitcnt vmcnt(0) lgkmcnt(0)" ::: "memory"); __builtin_amdgcn_s_barrier(); asm volatile("" ::: "memory");
#pragma unroll
        for (int hf = 0; hf < 2; ++hf)
#pragma unroll
            for (int i = 0; i < 2; ++i) vAc[hf][i] = ((unsigned)tab[hf * HALF + gR[i]] * (unsigned)K + (unsigned)gC[i]) * 2u;
    }
    const char* cA = (const char*)g.A + (GATHER ? (size_t)0 : (size_t)cur.pm * tstep); const char* cB = (const char*)g.Bt + (size_t)(cur.pm / g.tpg) * g.gstride + (size_t)cur.pn * tstep;
    S.a_ready(cur);
    if constexpr (SP2) {
        PG8_STAGE(PG8_SB(0, 0), cB, voffB); PG8_STAGE(PG8_SB(0, 1), cB + hstep, voffB); PG8_STAGE(PG8_SA(0, 0), cA, (GATHER ? vAc[0] : voffA)); PG8_STAGE(PG8_SA(0, 1), cA + hstepA, (GATHER ? vAc[1] : voffA));
        if (wr == 1) PG8_BAR;
        PG8_WAIT_V(2); PG8_BAR;
        PG8_STAGE(PG8_SB(1, 0), cB + kstep, voffB); PG8_STAGE(PG8_SA(1, 0), cA + kstep, (GATHER ? vAc[0] : voffA)); PG8_STAGE(PG8_SB(1, 1), cB + hstep + kstep, voffB);
        PG8_WAIT_V(6); PG8_BAR;
    } else {
        PG8_STAGE(PG8_SB(0, 0), cB, voffB); PG8_STAGE(PG8_SA(0, 0), cA, voffA); PG8_STAGE(PG8_SB(0, 1), cB + hstep, voffB); PG8_STAGE(PG8_SA(0, 1), cA + hstep, voffA);
        if (wr == 1) PG8_BAR;
        PG8_WAIT_V(4); PG8_BAR;
        PG8_STAGE(PG8_SB(1, 0), cB + kstep, voffB); PG8_STAGE(PG8_SA(1, 0), cA + kstep, voffA); PG8_STAGE(PG8_SB(1, 1), cB + hstep + kstep, voffB);
        PG8_WAIT_V(6); PG8_BAR;
    }
    for (;;) {
        const bool has_next = S.next(ui + 1, nxt);
        const char* nA = (has_next && !GATHER) ? (const char*)g.A + (size_t)nxt.pm * tstep : cA; const char* nB = has_next ? (const char*)g.Bt + (size_t)(nxt.pm / g.tpg) * g.gstride + (size_t)nxt.pn * tstep : cB;
        if constexpr (GATHER) { PG8_LAS int* tab = (PG8_LAS int*)(lds + g.tab_off);
#pragma unroll
            for (int hf = 0; hf < 2; ++hf)
#pragma unroll
                for (int i = 0; i < 2; ++i) vAn[hf][i] = has_next ? ((unsigned)tab[(ui + 1) * BM + hf * HALF + gR[i]] * (unsigned)K + (unsigned)gC[i]) * 2u : vAc[hf][i]; }
        for (int t = 0; t < nt; t += 2) {
            const bool last = (t == nt - 2);
            if constexpr (GATHER) {
#pragma unroll
                for (int hf = 0; hf < 2; ++hf)
#pragma unroll
                    for (int i = 0; i < 2; ++i) vS[hf][i] = last ? vAn[hf][i] : vAc[hf][i]; }
            const char* a1 = cA + (size_t)(t + 1) * kstep;
            const char* a2 = last ? nA : cA + (size_t)(t + 2) * kstep; const char* b2 = last ? nB : cB + (size_t)(t + 2) * kstep;
            const char* a3 = a2 + kstep; const char* b3 = b2 + kstep;
            if (last && has_next) S.a_ready(nxt);
            if constexpr (SP2) {
            PG8_LDB(B0, 0, 0); PG8_LDB(B1, 0, 1); PG8_SCHED; PG8_LDA(At, 0, 0); PG8_STAGE(PG8_SA(1, 1), a1 + hstepA, (GATHER ? vAc[1] : voffA));
            PG8_WAIT_V(8); PG8_WAIT_L(0); PG8_BAR; PG8_MMA(0, 0, At, B0); PG8_MMA(0, 1, At, B1); PG8_BAR; PG8_SCHED;
            PG8_LDA(At, 0, 1); PG8_STAGE(PG8_SB(0, 0), b2, voffB); PG8_STAGE(PG8_SB(0, 1), b2 + hstep, voffB); PG8_STAGE(PG8_SA(0, 0), a2, (GATHER ? vS[0] : voffA));
            PG8_WAIT_V(8); PG8_WAIT_L(0); PG8_BAR; PG8_MMA(1, 0, At, B0); PG8_MMA(1, 1, At, B1); PG8_BAR; PG8_SCHED;
            PG8_LDB(B0, 1, 0); PG8_LDB(B1, 1, 1); PG8_SCHED; PG8_LDA(At, 1, 0); PG8_STAGE(PG8_SA(0, 1), a2 + hstepA, (GATHER ? vS[1] : voffA));
            PG8_WAIT_V(8); PG8_WAIT_L(0); PG8_BAR; PG8_MMA(0, 0, At, B0); PG8_MMA(0, 1, At, B1); PG8_BAR; PG8_SCHED;
            PG8_LDA(At, 1, 1); PG8_STAGE(PG8_SB(1, 0), b3, voffB); PG8_STAGE(PG8_SB(1, 1), b3 + hstep, voffB); PG8_STAGE(PG8_SA(1, 0), a3, (GATHER ? vS[0] : voffA));
            PG8_WAIT_V(8); PG8_WAIT_L(0); PG8_BAR; PG8_MMA(1, 0, At, B0); PG8_MMA(1, 1, At, B1); PG8_BAR; PG8_SCHED;
            } else {
            PG8_LDB(B0, 0, 0); PG8_SCHED; PG8_LDA(At, 0, 0); PG8_STAGE(PG8_SA(1, 1), a1 + hstep, voffA);
            PG8_WAIT_L(8); PG8_BAR; PG8_WAIT_L(0); PG8_MMA(0, 0, At, B0); PG8_BAR; PG8_SCHED;
            PG8_LDB(B1, 0, 1); PG8_STAGE(PG8_SB(0, 0), b2, voffB);
            PG8_BAR; PG8_WAIT_L(0); PG8_MMA(0, 1, At, B1); PG8_BAR;
            PG8_LDA(At, 0, 1); PG8_STAGE(PG8_SA(0, 0), a2, voffA);
            PG8_BAR; PG8_WAIT_L(0); PG8_MMA(1, 0, At, B0); PG8_BAR; PG8_SCHED;
            PG8_STAGE(PG8_SB(0, 1), b2 + hstep, voffB);
            PG8_WAIT_V(6); PG8_BAR; PG8_MMA(1, 1, At, B1); PG8_BAR;
            PG8_LDB(B0, 1, 0); PG8_SCHED; PG8_LDA(At, 1, 0); PG8_STAGE(PG8_SA(0, 1), a2 + hstep, voffA);
            PG8_WAIT_L(8); PG8_BAR; PG8_WAIT_L(0); PG8_MMA(0, 0, At, B0); PG8_BAR; PG8_SCHED;
            PG8_LDB(B1, 1, 1); PG8_STAGE(PG8_SB(1, 0), b3, voffB);
            PG8_BAR; PG8_WAIT_L(0); PG8_MMA(0, 1, At, B1); PG8_BAR;
            PG8_LDA(At, 1, 1); PG8_STAGE(PG8_SA(1, 0), a3, voffA);
            PG8_BAR; PG8_WAIT_L(0); PG8_MMA(1, 0, At, B0); PG8_BAR; PG8_SCHED;
            PG8_STAGE(PG8_SB(1, 1), b3 + hstep, voffB);
            PG8_WAIT_V(6); PG8_BAR; PG8_MMA(1, 1, At, B1); PG8_BAR;
            }
        }
        if constexpr (ALIGN_EPI) { if (wr == 0) PG8_BAR; }
        if constexpr (FP8) {
            asm volatile("s_nop 15\n\ts_nop 15" : "+v"(acc[0][0][0][0]), "+v"(acc[0][0][0][1]), "+v"(acc[0][0][1][0]), "+v"(acc[0][0][1][1]), "+v"(acc[0][0][2][0]), "+v"(acc[0][0][2][1]), "+v"(acc[0][0][3][0]), "+v"(acc[0][0][3][1]),
                         "+v"(acc[0][1][0][0]), "+v"(acc[0][1][0][1]), "+v"(acc[0][1][1][0]), "+v"(acc[0][1][1][1]), "+v"(acc[0][1][2][0]), "+v"(acc[0][1][2][1]), "+v"(acc[0][1][3][0]), "+v"(acc[0][1][3][1]));
            asm volatile("" : "+v"(acc[1][0][0][0]), "+v"(acc[1][0][0][1]), "+v"(acc[1][0][1][0]), "+v"(acc[1][0][1][1]), "+v"(acc[1][0][2][0]), "+v"(acc[1][0][2][1]), "+v"(acc[1][0][3][0]), "+v"(acc[1][0][3][1]),
                         "+v"(acc[1][1][0][0]), "+v"(acc[1][1][0][1]), "+v"(acc[1][1][1][0]), "+v"(acc[1][1][1][1]), "+v"(acc[1][1][2][0]), "+v"(acc[1][1][2][1]), "+v"(acc[1][1][3][0]), "+v"(acc[1][1][3][1])); }
        if constexpr (!Epi::AFTER_DRAIN) { E(acc, cur, wr, wc, fr, fq); S.done(cur); }
        if (!has_next) break;
#pragma unroll
        for (int a = 0; a < 2; ++a)
#pragma unroll
            for (int b = 0; b < 2; ++b)
#pragma unroll
                for (int m = 0; m < 4; ++m)
#pragma unroll
                    for (int n = 0; n < 2; ++n) acc[a][b][m][n] = (f32x4){0.f, 0.f, 0.f, 0.f};
        cur = nxt; cA = nA; cB = nB; ++ui;
        if constexpr (GATHER) {
#pragma unroll
            for (int hf = 0; hf < 2; ++hf)
#pragma unroll
                for (int i = 0; i < 2; ++i) vAc[hf][i] = vAn[hf][i]; }
        if constexpr (ALIGN_EPI) { if (wr == 1) PG8_BAR; }
    }
    PG8_WAIT_V(0);
    if constexpr (!ALIGN_EPI) { if (wr == 0) PG8_BAR; }
    PG8_BAR;
    if constexpr (Epi::AFTER_DRAIN) { E.fused(acc, cur, wr, wc, fr, fq, lds, wid, lane); S.done(cur); }
#undef PG8_SA
#undef PG8_SB
#undef PG8_STAGE
#undef PG8_LD8
#undef PG8_LDA
#undef PG8_LDB
#undef PG8_MMA
#undef PG8_WAIT_V
#undef PG8_WAIT_L
#undef PG8_BAR
#undef PG8_SCHED
}
}
constexpr int NB = 16, SEQ = 2048, DM = 1024, MT = NB * SEQ;
constexpr int INC = 3488, INCP = 3584;
constexpr int NE = 16, CAP = 256, DFF = 2048, NGRP = 2, EPG = NE / NGRP, MG = EPG * NB * CAP;
constexpr int C_Q = 0, C_K = 512, C_V = 1024, C_RW = 1536, C_RR = 1536, C_RK = 2048, C_RV = 2560, C_WL = 3072, C_AL = 3200, C_GL = 3328;
constexpr float NORM_EPS = 1e-6f, RW_LN_EPS = 64e-5f, LOG2E = 1.4426950408889634f;
constexpr int NWAVES = 8, NTHR = 512;
enum { I_X = 0, I_P, I_RELB, I_GMIX, I_WIN, I_WOUT, I_QG, I_KG, I_LQ1, I_LK1, I_LQ2, I_LK2, I_SUBLN, I_MU, I_W0, I_W2L, I_A0, I_A2L, I_G2L, I_KK, I_KA, I_RK, I_LNG, I_LNB,
       I_GFFN, I_WR, I_W1, I_W3, I_W2, I_GPLE, I_WPG, I_WPLE, I_GPOST, N_IN };
constexpr size_t MiB = 1u << 20;
constexpr size_t WS_CTL = 0, CTL_ZERO_BYTES = 1 * MiB;
constexpr size_t WS_WIN = 1 * MiB, WS_WOUT = 8 * MiB, WS_WPG = 10 * MiB, WS_WPLE = 12 * MiB;
constexpr size_t WS_LW2 = 12 * MiB + 512 * 1024, WS_LA2 = WS_LW2 + 131072, WS_LG2 = WS_LA2 + 131072;
constexpr size_t WS_XN = 14 * MiB, WS_QN = 14 * MiB, WS_KN = 46 * MiB;
constexpr size_t WS_HB = 14 * MiB;
constexpr size_t WS_H2B = 334 * MiB;
constexpr size_t WS_HN8 = 430 * MiB;
constexpr size_t WS_U = 78 * MiB;
constexpr size_t WS_W13 = 462 * MiB, WS_W2T = 142 * MiB;
constexpr size_t WS_YE = 174 * MiB;
constexpr size_t WS_HDN = 302 * MiB;
constexpr size_t WS_HN2 = 302 * MiB;
constexpr size_t WS_VT = 302 * MiB, WS_MIX = 334 * MiB, WS_Y = 398 * MiB, WS_BON = 526 * MiB, WS_PB = 544 * MiB;
constexpr size_t WS_PE = 78 * MiB;
constexpr size_t WS_AFF = 526 * MiB, WS_SEL = 528 * MiB, WS_RMAP = 530 * MiB, WS_GATE = WS_RMAP + 262144, WS_PERS = WS_GATE + 262144;
constexpr int TAB_OFF = 132096;
constexpr size_t WS_END = 560 * MiB;
constexpr int CW_TMO = 0, CW_CODE = 1, CW_BAR = 4096;
constexpr int RING_OFF = 0, RING_BYTES = 131072, LDSCTL_OFF = RING_BYTES, MISC_OFF = LDSCTL_OFF + 320, LDS_BYTES = 148480;

#define GAS __attribute__((address_space(1)))
#define LAS __attribute__((address_space(3)))
typedef unsigned short bf16;
typedef unsigned v4u __attribute__((ext_vector_type(4)));
typedef unsigned v2u __attribute__((ext_vector_type(2)));
typedef float f32x4 __attribute__((ext_vector_type(4)));
typedef float f32x16 __attribute__((ext_vector_type(16)));
typedef short bf16x8 __attribute__((ext_vector_type(8)));
typedef GAS unsigned gu32;
#define RLX_AGENT __ATOMIC_RELAXED, __HIP_MEMORY_SCOPE_AGENT
#define LDS_WAIT() asm volatile("s_waitcnt lgkmcnt(0)" ::: "memory")
#define VM_WAIT() asm volatile("s_waitcnt vmcnt(0)" ::: "memory")
#define WG_BAR() do { asm volatile("s_waitcnt lgkmcnt(0)" ::: "memory"); __builtin_amdgcn_s_barrier(); asm volatile("" ::: "memory"); } while (0)
#define MFMA32(a, b, c) __builtin_amdgcn_mfma_f32_32x32x16_bf16((a), (b), (c), 0, 0, 0)
using pg8::cvt_pk_bf16; using pg8::fast_sigmoid;
__device__ __forceinline__ float bflo(unsigned w) { return __builtin_bit_cast(float, w << 16); }
__device__ __forceinline__ float bfhi(unsigned w) { return __builtin_bit_cast(float, w & 0xffff0000u); }
__device__ __forceinline__ void unpack8(const v4u w, float (&f)[8]) { f[0] = bflo(w.x); f[1] = bfhi(w.x); f[2] = bflo(w.y); f[3] = bfhi(w.y); f[4] = bflo(w.z); f[5] = bfhi(w.z); f[6] = bflo(w.w); f[7] = bfhi(w.w); }
__device__ __forceinline__ v4u pack8(const float (&f)[8]) { v4u w; w.x = cvt_pk_bf16(f[0], f[1]); w.y = cvt_pk_bf16(f[2], f[3]); w.z = cvt_pk_bf16(f[4], f[5]); w.w = cvt_pk_bf16(f[6], f[7]); return w; }
__device__ __forceinline__ float fexp2(float x) { return __builtin_amdgcn_exp2f(x); }
__device__ __forceinline__ float frcp(float x) { return __builtin_amdgcn_rcpf(x); }
__device__ __forceinline__ float wave_sum(float v) {
#pragma unroll
    for (int o = 1; o < 64; o <<= 1) v += __shfl_xor(v, o);
    return v;
}
template <int CTRL> __device__ __forceinline__ float dpp_f(float x) { return __builtin_bit_cast(float, __builtin_amdgcn_update_dpp(0, __builtin_bit_cast(int, x), CTRL, 0xF, 0xF, true)); }
__device__ __forceinline__ float sum8(float p) { p += dpp_f<0xB1>(p); p += dpp_f<0x4E>(p); p += dpp_f<0x141>(p); return p; }

#define XB_TMO      128
#define XB_XCNT(j)  (256  + 64 * (j))
#define XB_XSUB(j)  (1280 + 64 * (j))
#define XB_XGEN(j)  (2304 + 64 * (j))
#define XB_TOP      3328
#define XB_TOPGEN   3392
#define XCD_BAR_WORDS 3456
#define XB_SPIN_CAP (1u << 18)
__device__ __forceinline__ unsigned xb_ld(unsigned* p)              { return __hip_atomic_load(p, __ATOMIC_RELAXED, __HIP_MEMORY_SCOPE_AGENT); }
__device__ __forceinline__ unsigned xb_add(unsigned* p, unsigned v) { return __hip_atomic_fetch_add(p, v, __ATOMIC_RELAXED, __HIP_MEMORY_SCOPE_AGENT); }
__device__ __forceinline__ unsigned xb_xcc_id() { return (unsigned)__builtin_amdgcn_s_getreg((3 << 11) | 20) & 0xFu; }
#define XB_SPIN(cond, bar) do { unsigned _sp = 0; while (cond) { __builtin_amdgcn_s_sleep(1); \
    if ((++_sp & 255u) == 0u) { if (xb_ld(&(bar)[XB_TMO])) break; if (_sp > XB_SPIN_CAP) { atomicAdd(&(bar)[XB_TMO], 1u); break; } } } } while (0)
__device__ __forceinline__ int fresh_lane() { int l; asm volatile("v_mbcnt_lo_u32_b32 %0, -1, 0\n\tv_mbcnt_hi_u32_b32 %0, -1, %0" : "=v"(l)); return l; }
struct XcdBarrier { unsigned* bar; unsigned x; volatile LAS unsigned* st; int w; };
__device__ __forceinline__ XcdBarrier xcd_barrier_post(unsigned* bar, volatile LAS unsigned* st, int wave) {
    XcdBarrier b; b.bar = bar; b.x = xb_xcc_id(); b.st = st; b.w = wave;
    if (wave == 0 && fresh_lane() == 0) (void)xb_add(&bar[XB_XCNT(b.x)], 1u);
    return b;
}
__device__ __forceinline__ void xcd_barrier_complete(unsigned* bar, unsigned x, unsigned& nloc, unsigned& nx) {
    const unsigned G = gridDim.x * gridDim.y * gridDim.z;
    unsigned sum, cnt, mine, sp = 0u;
    for (;;) {
        sum = 0u; cnt = 0u; mine = 0u;
#pragma unroll
        for (unsigned j = 0; j < 16; ++j) { const unsigned c = xb_ld(&bar[XB_XCNT(j)]); sum += c; cnt += (c > 0u) ? 1u : 0u; mine = (j == x) ? c : mine; }
        if (sum == G) break;
        __builtin_amdgcn_s_sleep(1);
        if ((++sp & 255u) == 0u) { if (xb_ld(&bar[XB_TMO])) break; if (sp > XB_SPIN_CAP) { atomicAdd(&bar[XB_TMO], 1u); break; } }
    }
    nloc = mine > 0u ? mine : 1u; nx = cnt > 0u ? cnt : 1u;
}
__device__ __forceinline__ void xcd_barrier(const XcdBarrier& b) {
    asm volatile("s_waitcnt vmcnt(0)" ::: "memory");
    __syncthreads();
    if (b.w == 0 && fresh_lane() == 0) {
        unsigned* bar = b.bar;
        __builtin_amdgcn_s_waitcnt(0);
        unsigned nloc = b.st[0], nx = b.st[1];
        if (nloc == 0u) { xcd_barrier_complete(bar, b.x, nloc, nx); b.st[0] = nloc; b.st[1] = nx; }
        const unsigned old = xb_add(&bar[XB_XSUB(b.x)], 1u);
        const unsigned gen = old / nloc;
        if (old + 1u == (gen + 1u) * nloc) {
            __builtin_amdgcn_fence(__ATOMIC_RELEASE, "agent");
            asm volatile("s_waitcnt vmcnt(0)" ::: "memory");
            const unsigned og = xb_add(&bar[XB_TOP], 1u);
            const unsigned tg = og / nx;
            if (og + 1u == (tg + 1u) * nx) xb_add(&bar[XB_TOPGEN], 1u);
            else XB_SPIN(xb_ld(&bar[XB_TOPGEN]) == tg, bar);
            __builtin_amdgcn_fence(__ATOMIC_ACQUIRE, "agent");
            xb_add(&bar[XB_XGEN(b.x)], 1u);
            asm volatile("s_waitcnt vmcnt(0)" ::: "memory");
        } else {
            XB_SPIN(xb_ld(&bar[XB_XGEN(b.x)]) == gen, bar);
            __builtin_amdgcn_fence(__ATOMIC_ACQUIRE, "agent");
            asm volatile("s_waitcnt vmcnt(0)" ::: "memory");
        }
    }
    __syncthreads();
}

struct Args { const float* in[N_IN]; float* out; unsigned char* ws; int ph_lo, ph_hi, li, pad; };
struct Ctx { LAS unsigned char* lds; int tid, lane, wave, G, vcu; };

__device__ __forceinline__ void transpose_item(const float* W, int N, bf16* WT, int ldo, int dest_row0, int k0, int n0, LAS float* scr, int lane) {
#pragma unroll 8
    for (int i = 0; i < 32; ++i) { const int kk = 2 * i + (lane >> 5); scr[kk * 33 + (lane & 31)] = W[(size_t)(k0 + kk) * N + n0 + (lane & 31)]; }
    LDS_WAIT(); asm volatile("" ::: "memory");
    const int c = lane & 7;
#pragma unroll
    for (int j = 0; j < 4; ++j) { const int n = (lane >> 3) + 8 * j; const LAS float* s = scr + (8 * c) * 33 + n;
        v4u o; o.x = cvt_pk_bf16(s[0 * 33], s[1 * 33]); o.y = cvt_pk_bf16(s[2 * 33], s[3 * 33]); o.z = cvt_pk_bf16(s[4 * 33], s[5 * 33]); o.w = cvt_pk_bf16(s[6 * 33], s[7 * 33]);
        *(GAS v4u*)(WT + (size_t)(dest_row0 + n) * ldo + k0 + 8 * c) = o; }
    LDS_WAIT(); asm volatile("" ::: "memory");
}
__device__ __forceinline__ void transpose_item_fp8(const float* W, int N, unsigned char* WT, int ldo, int dest_row0, int k0, int n0, float scale, LAS float* scr, int lane) {
#pragma unroll 8
    for (int i = 0; i < 32; ++i) { const int kk = 2 * i + (lane >> 5); scr[kk * 33 + (lane & 31)] = W[(size_t)(k0 + kk) * N + n0 + (lane & 31)]; }
    LDS_WAIT(); asm volatile("" ::: "memory");
    const int c = lane & 3;
#pragma unroll
    for (int j = 0; j < 2; ++j) { const int n = (lane >> 2) + 16 * j; const LAS float* sp = scr + (16 * c) * 33 + n;
        v4u o; o.x = pg8::cvt4_fp8(sp[0 * 33] * scale, sp[1 * 33] * scale, sp[2 * 33] * scale, sp[3 * 33] * scale); o.y = pg8::cvt4_fp8(sp[4 * 33] * scale, sp[5 * 33] * scale, sp[6 * 33] * scale, sp[7 * 33] * scale);
        o.z = pg8::cvt4_fp8(sp[8 * 33] * scale, sp[9 * 33] * scale, sp[10 * 33] * scale, sp[11 * 33] * scale); o.w = pg8::cvt4_fp8(sp[12 * 33] * scale, sp[13 * 33] * scale, sp[14 * 33] * scale, sp[15 * 33] * scale);
        *(GAS v4u*)(WT + (size_t)(dest_row0 + n) * ldo + k0 + 16 * c) = o; }
    LDS_WAIT(); asm volatile("" ::: "memory");
}
constexpr float WSCALE = 32.0f; constexpr int WSCALE_E8M0 = 0x7a7a7a7a;
__device__ __forceinline__ void p0_prologue(const Args& a, const Ctx& F) {
    unsigned char* ws = a.ws;
    LAS float* scr = (LAS float*)(F.lds + RING_OFF + F.wave * 16384);
    const int gw = F.vcu * NWAVES + F.wave, NGW = F.G * NWAVES;
    constexpr int I0 = 16 * 109, I1 = I0 + 512, I2 = I1 + 512, I3 = I2 + 128, I4 = I3 + 32, I5 = I4 + 32;
    for (int it = gw; it < I5; it += NGW) {
        if (it < I0) { const int kb = it / 109, nb = it % 109; transpose_item(a.in[I_WIN], INC, (bf16*)(ws + WS_WIN), DM, 32 * nb, 64 * kb, 32 * nb, scr, F.lane); }
        else if (it < I1) { const int r = it - I0, kb = r >> 5, nb = r & 31; transpose_item(a.in[I_WOUT], DM, (bf16*)(ws + WS_WOUT), DM, 32 * nb, 64 * kb, 32 * nb, scr, F.lane); }
        else if (it < I2) { const int r = it - I1, kb = r >> 5, nb = r & 31; transpose_item_fp8(a.in[I_WPG], DM, ws + WS_WPG, DM, 32 * nb, 64 * kb, 32 * nb, WSCALE, scr, F.lane); }
        else if (it < I3) { const int r = it - I2, kb = r >> 5, nb = r & 31; transpose_item(a.in[I_WPLE], DM, (bf16*)(ws + WS_WPLE), 256, 32 * nb, 64 * kb, 32 * nb, scr, F.lane); }
        else if (it < I4) { const int r = it - I3, d = r >> 4, nb = r & 15; transpose_item(a.in[I_W2L] + (size_t)d * 64 * 512, 512, (bf16*)(ws + WS_LW2) + (size_t)d * 512 * 64, 64, 32 * nb, 0, 32 * nb, scr, F.lane); }
        else { const int r = it - I4, d = r >> 4, nb = r & 15; transpose_item(a.in[I_A2L] + (size_t)d * 64 * 512, 512, (bf16*)(ws + WS_LA2) + (size_t)d * 512 * 64, 64, 32 * nb, 0, 32 * nb, scr, F.lane); }
    }
    const int gt = F.vcu * NTHR + F.tid, NGT = F.G * NTHR;
    for (int i = gt; i < (INCP - INC) * DM / 8; i += NGT) *(GAS v4u*)((bf16*)(ws + WS_WIN) + (size_t)INC * DM + (size_t)i * 8) = (v4u){0u, 0u, 0u, 0u};
    for (int i = gt; i < 512 * 192; i += NGT) { const int n = i / 192, k = i % 192; const float v = k < 160 ? a.in[I_G2L][(size_t)k * 512 + n] : 0.f; ((bf16*)(ws + WS_LG2))[i] = (bf16)(cvt_pk_bf16(v, 0.f) & 0xffffu); }
    for (int i = gt; i < MT * 256 / 8; i += NGT) { const f32x4 x0 = *(const GAS f32x4*)(a.in[I_P] + (size_t)i * 8), x1 = *(const GAS f32x4*)(a.in[I_P] + (size_t)i * 8 + 4);
        v4u o; o.x = cvt_pk_bf16(x0[0], x0[1]); o.y = cvt_pk_bf16(x0[2], x0[3]); o.z = cvt_pk_bf16(x1[0], x1[1]); o.w = cvt_pk_bf16(x1[2], x1[3]); *(GAS v4u*)((bf16*)(ws + WS_PB) + (size_t)i * 8) = o; }
    const float* gm = a.in[I_GMIX];
    for (int m = gw; m < MT; m += 4 * NGW) {
        f32x4 v[4][4];
#pragma unroll
        for (int r = 0; r < 4; ++r) { const int mr = min(m + r * NGW, MT - 1); const GAS f32x4* xr = (const GAS f32x4*)(a.in[I_X] + (size_t)mr * DM) + F.lane;
#pragma unroll
            for (int j = 0; j < 4; ++j) v[r][j] = xr[64 * j]; }
#pragma unroll
        for (int r = 0; r < 4; ++r) { const int mr = m + r * NGW; float s = 0.f;
#pragma unroll
            for (int j = 0; j < 4; ++j) s += (v[r][j][0] * v[r][j][0] + v[r][j][1] * v[r][j][1]) + (v[r][j][2] * v[r][j][2] + v[r][j][3] * v[r][j][3]);
            const float rstd = 1.0f / sqrtf(wave_sum(s) * (1.f / DM) + NORM_EPS);
            if (mr < MT) { GAS v2u* o8 = (GAS v2u*)((bf16*)(ws + WS_XN) + (size_t)mr * DM) + F.lane;
#pragma unroll
                for (int j = 0; j < 4; ++j) { const f32x4 g = *(const f32x4*)(gm + 4 * F.lane + 256 * j); v2u o; o.x = cvt_pk_bf16(v[r][j][0] * rstd * g[0], v[r][j][1] * rstd * g[1]); o.y = cvt_pk_bf16(v[r][j][2] * rstd * g[2], v[r][j][3] * rstd * g[3]); o8[64 * j] = o; } } }
    }
}
struct ConvItem { const float* src; unsigned char* dst; };
template <int KIND> __device__ __forceinline__ ConvItem conv_item(const Args& a, int it) {
    ConvItem c;
    if constexpr (KIND == 0) { const int e = it >> 11, r = it & 2047, w3 = r >> 10, q = r & 1023, kb = q >> 6, nb = q & 63, n0 = 32 * nb;
        c.src = a.in[w3 ? I_W3 : I_W1] + (size_t)e * DM * DFF + (size_t)(64 * kb) * DFF + n0;
        c.dst = a.ws + WS_W13 + (size_t)e * 4096 * DM + (size_t)(256 * (n0 >> 7) + (n0 & 127) + 128 * w3) * DM + 64 * kb; }
    else { const int e = it >> 10, q = it & 1023, kb = q >> 5, nb = q & 31;
        c.src = a.in[I_W2] + (size_t)e * DFF * DM + (size_t)(64 * kb) * DM + 32 * nb;
        c.dst = a.ws + WS_W2T + (size_t)e * DM * DFF + (size_t)(32 * nb) * DFF + 64 * kb; }
    return c;
}
template <int KIND> __device__ __forceinline__ void conv_stream(const Args& a, const Ctx& F, int j0, int j1) {
    constexpr int TOTAL = KIND == 0 ? NE * 2048 : NE * 1024, PS = KIND == 0 ? DFF : DM, PD = KIND == 0 ? DM : DFF;
    LAS float* scr = (LAS float*)(F.lds + RING_OFF + F.wave * 16384);
    const int gw = F.vcu * NWAVES + F.wave, NGW = F.G * NWAVES, lane = F.lane;
    { const int jmax = (TOTAL - gw + NGW - 1) / NGW; if (j1 > jmax) j1 = jmax; }
    if (j0 >= j1) return;
    const int lo = (lane >> 5) * PS + (lane & 31);
    float va[32], vb[32]; unsigned char* da; unsigned char* db = nullptr;
    { const ConvItem c = conv_item<KIND>(a, gw + j0 * NGW); da = c.dst;
#pragma unroll
      for (int i = 0; i < 32; ++i) va[i] = c.src[(size_t)(2 * i) * PS + lo]; }
    if (j0 + 1 < j1) { const ConvItem c = conv_item<KIND>(a, gw + (j0 + 1) * NGW); db = c.dst;
#pragma unroll
      for (int i = 0; i < 32; ++i) vb[i] = c.src[(size_t)(2 * i) * PS + lo]; }
#define CONV_STEP(v_, d_, j_) { unsigned char* dst = d_; \
        _Pragma("unroll") for (int i = 0; i < 32; ++i) scr[(2 * i + (lane >> 5)) * 33 + (lane & 31)] = v_[i]; \
        if ((j_) + 2 < j1) { const ConvItem c = conv_item<KIND>(a, gw + ((j_) + 2) * NGW); d_ = c.dst; \
            _Pragma("unroll") for (int i = 0; i < 32; ++i) v_[i] = c.src[(size_t)(2 * i) * PS + lo]; } \
        LDS_WAIT(); asm volatile("" ::: "memory"); \
        const int cq = lane & 3; \
        _Pragma("unroll") for (int jj = 0; jj < 2; ++jj) { const int n = (lane >> 2) + 16 * jj; const LAS float* sp = scr + (16 * cq) * 33 + n; \
            v4u o; o.x = pg8::cvt4_fp8(sp[0 * 33] * WSCALE, sp[1 * 33] * WSCALE, sp[2 * 33] * WSCALE, sp[3 * 33] * WSCALE); o.y = pg8::cvt4_fp8(sp[4 * 33] * WSCALE, sp[5 * 33] * WSCALE, sp[6 * 33] * WSCALE, sp[7 * 33] * WSCALE); \
            o.z = pg8::cvt4_fp8(sp[8 * 33] * WSCALE, sp[9 * 33] * WSCALE, sp[10 * 33] * WSCALE, sp[11 * 33] * WSCALE); o.w = pg8::cvt4_fp8(sp[12 * 33] * WSCALE, sp[13 * 33] * WSCALE, sp[14 * 33] * WSCALE, sp[15 * 33] * WSCALE); \
            *(GAS v4u*)(dst + (size_t)n * PD + 16 * cq) = o; } \
        LDS_WAIT(); asm volatile("" ::: "memory"); }
    for (int j = j0; j < j1; j += 2) {
        CONV_STEP(va, da, j)
        if (j + 1 < j1) CONV_STEP(vb, db, j + 1)
    }
#undef CONV_STEP
}
__device__ __forceinline__ void p2_attn_prep(const Args& a, const Ctx& F) {
    unsigned char* ws = a.ws; const bf16* U = (const bf16*)(ws + WS_U);
    bf16* QN = (bf16*)(ws + WS_QN); bf16* KN = (bf16*)(ws + WS_KN); bf16* VT = (bf16*)(ws + WS_VT);
    const int lane = F.lane, sv = lane >> 2, d0 = (lane & 3) * 16;
    float gq[16];
    { const float* g = (sv < 8) ? a.in[I_QG] : a.in[I_KG]; const float sc = (sv < 8) ? 0.125f * LOG2E : 1.0f;
#pragma unroll
      for (int i = 0; i < 16; ++i) gq[i] = g[d0 + i] * sc; }
    for (int u = F.vcu; u < MT / 64; u += F.G) {
        const int m0 = u * 64, b = m0 / SEQ, s0 = m0 % SEQ;
#pragma unroll 2
        for (int i = 0; i < 8; ++i) { const int tk = F.wave * 8 + i; const bf16* row = U + (size_t)(m0 + tk) * INCP + lane * 16;
            const v4u w0 = *(const GAS v4u*)row, w1 = *(const GAS v4u*)(row + 8);
            float x[16]; { float t0[8], t1[8]; unpack8(w0, t0); unpack8(w1, t1);
#pragma unroll
              for (int j = 0; j < 8; ++j) { x[j] = t0[j]; x[8 + j] = t1[j]; } }
            float ss = 0.f;
#pragma unroll
            for (int j = 0; j < 16; ++j) ss += x[j] * x[j];
            ss += dpp_f<0xB1>(ss); ss += dpp_f<0x4E>(ss);
            const float rn = 1.0f / sqrtf(ss * (1.f / 64.f) + NORM_EPS);
            float y0[8], y1[8];
#pragma unroll
            for (int j = 0; j < 8; ++j) { y0[j] = x[j] * rn * gq[j]; y1[j] = x[8 + j] * rn * gq[8 + j]; }
            const int svl = sv & 7, hh = svl >> 1, c = svl & 1;
            bf16* dst = ((sv < 8) ? QN : KN) + ((size_t)((b * 4 + hh) * 2 + c) * SEQ + s0 + tk) * 64 + d0;
            *(GAS v4u*)dst = pack8(y0); *(GAS v4u*)(dst + 8) = pack8(y1); }
        LAS unsigned char* T = F.lds + RING_OFF;
#pragma unroll
        for (int i = 0; i < 8; ++i) { const int p = F.tid + 512 * i, tk = p >> 6, ch = p & 63;
            const v4u w = *(const GAS v4u*)(U + (size_t)(m0 + tk) * INCP + C_V + ch * 8); *(LAS v4u*)(T + tk * 1040 + ch * 16) = w; }
        LDS_WAIT(); __syncthreads();
        { const int dv = F.tid;
          bf16* dst = VT + ((size_t)(b * 4 + (dv >> 7)) * 128 + (dv & 127)) * SEQ + s0;
#pragma unroll
          for (int g = 0; g < 8; ++g) { unsigned short e[8];
#pragma unroll
              for (int j = 0; j < 8; ++j) e[j] = *(const LAS unsigned short*)(T + (8 * g + j) * 1040 + dv * 2);
              v4u o; o.x = e[0] | ((unsigned)e[1] << 16); o.y = e[2] | ((unsigned)e[3] << 16); o.z = e[4] | ((unsigned)e[5] << 16); o.w = e[6] | ((unsigned)e[7] << 16);
              *(GAS v4u*)(dst + 8 * g) = o; } }
        LDS_WAIT(); __syncthreads();
    }
}

__device__ __forceinline__ void mix8(const bf16* Ub, int t, int col, const float* mu, float (&x)[8]) {
    const v4u z = {0u, 0u, 0u, 0u};
    const v4u w0 = *(const GAS v4u*)(Ub + (size_t)t * INCP + col);
    const v4u wm = (t > 0) ? *(const GAS v4u*)(Ub + (size_t)(t - 1) * INCP + col) : z;
    const v4u wp = (t < SEQ - 1) ? *(const GAS v4u*)(Ub + (size_t)(t + 1) * INCP + col) : z;
    const f32x4 m0 = *(const f32x4*)(mu + col - C_RW), m1 = *(const f32x4*)(mu + col - C_RW + 4);
    float u0[8], um[8], up[8]; unpack8(w0, u0); unpack8(wm, um); unpack8(wp, up);
#pragma unroll
    for (int j = 0; j < 8; ++j) { const float mj = j < 4 ? m0[j] : m1[j - 4]; x[j] = u0[j] + mj * (0.5f * (um[j] + up[j]) - u0[j]); }
}
__device__ __forceinline__ int t5_bucket(int rel) {
    const int n = rel < 0 ? -rel : rel; const int ret = rel > 0 ? 16 : 0;
    int lg = 8 + (n >= 12) + (n >= 16) + (n >= 23) + (n >= 32) + (n >= 46) + (n >= 64) + (n >= 91); lg = lg < 15 ? lg : 15;
    return ret + (n < 8 ? n : lg);
}
__device__ __forceinline__ int swz(int row, int chunk) { return row * 128 + ((chunk ^ ((row >> 1) & 7)) << 4); }
__device__ __forceinline__ void p3_attn_unit(const Args& a, const Ctx& F, int unit, float lam) {
    unsigned char* ws = a.ws;
    const int b = unit >> 6, h = (unit >> 4) & 3, qt = unit & 15, q0 = qt * 128;
    int tid_ = F.tid, wave_ = F.wave; asm volatile("" : "+v"(tid_), "+s"(wave_));
    const int tid = tid_, lane = tid & 63, wave = wave_, c = wave >> 2, qw = wave & 3, l31 = lane & 31, hh = lane >> 5;
    const bf16* KNb = (const bf16*)(ws + WS_KN) + (size_t)((b * 4 + h) * 2) * SEQ * 64;
    const bf16* VTb = (const bf16*)(ws + WS_VT) + (size_t)(b * 4 + h) * 128 * SEQ;
    LAS unsigned char* KV = F.lds + RING_OFF;
    LAS float* BT = (LAS float*)(F.lds + RING_OFF + 65536);
    const float* relb = a.in[I_RELB];
    for (int i = tid; i < 641; i += NTHR) BT[i] = relb[t5_bucket(i - 320) * 4 + h] * LOG2E;
    const float cL = relb[15 * 4 + h] * LOG2E, cR = relb[31 * 4 + h] * LOG2E;
    bf16x8 qf[4];
    { const bf16* Qp = (const bf16*)(ws + WS_QN) + ((size_t)((b * 4 + h) * 2 + c) * SEQ + q0 + 32 * qw + l31) * 64 + 8 * hh;
#pragma unroll
      for (int ks = 0; ks < 4; ++ks) qf[ks] = *(const GAS bf16x8*)(Qp + 16 * ks); }
    const bf16* gsrc[4]; int ldst[4];
#pragma unroll
    for (int i = 0; i < 4; ++i) { const int p = tid + 512 * i;
        if (p < 1024) { const int cc = p >> 9, row = (p & 511) >> 3, ch = p & 7; gsrc[i] = KNb + ((size_t)cc * SEQ + row) * 64 + ch * 8; ldst[i] = cc * 8192 + swz(row, ch); }
        else { const int q = p - 1024, row = q >> 3, ch = q & 7; gsrc[i] = VTb + (size_t)row * SEQ + ch * 8; ldst[i] = 16384 + swz(row, ch); } }
    const int pr = (l31 & 19) | ((l31 & 4) << 1) | ((l31 & 8) >> 1);
    f32x16 O[4];
#pragma unroll
    for (int d = 0; d < 4; ++d)
#pragma unroll
        for (int i = 0; i < 16; ++i) O[d][i] = 0.f;
    float mrun = -1e30f, lrun = 0.f;
    const int qpos = q0 + 32 * qw + l31;
    v4u stg[4];
#pragma unroll
    for (int i = 0; i < 4; ++i) stg[i] = *(const GAS v4u*)(gsrc[i] + (i < 2 ? 0 : 0));
#pragma unroll
    for (int i = 0; i < 4; ++i) *(LAS v4u*)(KV + ldst[i]) = stg[i];
    LDS_WAIT(); __syncthreads();
    for (int t = 0; t < SEQ / 64; ++t) {
        const int k0 = t * 64; LAS unsigned char* buf = KV + (t & 1) * 32768;
        if (t + 1 < SEQ / 64) {
#pragma unroll
            for (int i = 0; i < 4; ++i) stg[i] = *(const GAS v4u*)(gsrc[i] + (i < 2 ? (size_t)(k0 + 64) * 64 : (size_t)(k0 + 64)));
        }
        f32x16 st[2];
#pragma unroll
        for (int kt = 0; kt < 2; ++kt)
#pragma unroll
            for (int i = 0; i < 16; ++i) st[kt][i] = 0.f;
#pragma unroll
        for (int ks = 0; ks < 4; ++ks)
#pragma unroll
            for (int kt = 0; kt < 2; ++kt) { const bf16x8 kf = *(const LAS bf16x8*)(buf + c * 8192 + swz(32 * kt + pr, 2 * ks + hh)); st[kt] = MFMA32(kf, qf[ks], st[kt]); }
        const int relmax = k0 + 63 - q0, relmin = k0 - q0 - 127;
        float cb = 0.f;
        if (relmax <= -91) cb = cL; else if (relmin >= 91) cb = cR;
        else { int boff_ = (k0 - qpos + 320 + 8 * hh) * 4 + 65536; asm volatile("" : "+v"(boff_)); const LAS float* btp_ = (const LAS float*)(F.lds + RING_OFF + boff_);
#pragma unroll
            for (int kt = 0; kt < 2; ++kt)
#pragma unroll
                for (int r = 0; r < 16; ++r) st[kt][r] += btp_[32 * kt + 16 * (r >> 3) + (r & 7)];
        }
        float mx = st[0][0];
#pragma unroll
        for (int kt = 0; kt < 2; ++kt)
#pragma unroll
            for (int r = 0; r < 16; ++r) mx = fmaxf(mx, st[kt][r]);
        mx += cb;
        mx = fmaxf(mx, __shfl_xor(mx, 32));
        if (__any(mx - mrun > 8.0f)) {
            const float mnew = fmaxf(mrun, mx), alpha = fexp2(mrun - mnew); mrun = mnew; lrun *= alpha;
#pragma unroll
            for (int d = 0; d < 4; ++d)
#pragma unroll
                for (int i = 0; i < 16; ++i) O[d][i] *= alpha; }
        const float sub = cb - mrun;
        float ps = 0.f;
#pragma unroll
        for (int kt = 0; kt < 2; ++kt)
#pragma unroll
            for (int r = 0; r < 16; ++r) { st[kt][r] = fexp2(st[kt][r] + sub); ps += st[kt][r]; }
        lrun += ps;
        bf16x8 pf[2][2];
#pragma unroll
        for (int kt = 0; kt < 2; ++kt)
#pragma unroll
            for (int s2 = 0; s2 < 2; ++s2) { v4u w; w.x = cvt_pk_bf16(st[kt][8 * s2 + 0], st[kt][8 * s2 + 1]); w.y = cvt_pk_bf16(st[kt][8 * s2 + 2], st[kt][8 * s2 + 3]); w.z = cvt_pk_bf16(st[kt][8 * s2 + 4], st[kt][8 * s2 + 5]); w.w = cvt_pk_bf16(st[kt][8 * s2 + 6], st[kt][8 * s2 + 7]);
                pf[kt][s2] = __builtin_bit_cast(bf16x8, w); }
#pragma unroll
        for (int kt = 0; kt < 2; ++kt)
#pragma unroll
            for (int s2 = 0; s2 < 2; ++s2)
#pragma unroll
                for (int d = 0; d < 4; ++d) { const bf16x8 vf = *(const LAS bf16x8*)(buf + 16384 + swz(32 * d + l31, 4 * kt + 2 * s2 + hh)); O[d] = MFMA32(vf, pf[kt][s2], O[d]); }
        if (t + 1 < SEQ / 64) { LAS unsigned char* nb = KV + ((t + 1) & 1) * 32768;
#pragma unroll
            for (int i = 0; i < 4; ++i) *(LAS v4u*)(nb + ldst[i]) = stg[i]; }
        LDS_WAIT(); __syncthreads();
    }
    const float ltot = lrun + __shfl_xor(lrun, 32), linv = 1.0f / ltot;
    LAS float* X = (LAS float*)(F.lds + RING_OFF);
    if (c == 1) {
        const float sc = lam * linv;
#pragma unroll
        for (int d = 0; d < 4; ++d)
#pragma unroll
            for (int r = 0; r < 16; ++r) X[((qw * 4 + d) * 16 + r) * 64 + lane] = O[d][r] * sc;
    }
    LDS_WAIT(); __syncthreads();
    if (c == 0) {
        float ssq = 0.f;
#pragma unroll
        for (int d = 0; d < 4; ++d)
#pragma unroll
            for (int r = 0; r < 16; ++r) { const float o = O[d][r] * linv - X[((qw * 4 + d) * 16 + r) * 64 + lane]; O[d][r] = o; ssq += o * o; }
        ssq += __shfl_xor(ssq, 32);
        const float rn = (1.0f / sqrtf(ssq * (1.f / 128.f) + NORM_EPS)) * 0.8f;
        const float* sg = a.in[I_SUBLN];
        bf16* orow = (bf16*)(ws + WS_MIX) + (size_t)(b * SEQ + qpos) * DM + h * 128;
#pragma unroll
        for (int d = 0; d < 4; ++d)
#pragma unroll
            for (int g = 0; g < 4; ++g) { const int dv = 32 * d + 8 * g + 4 * hh; const f32x4 gg = *(const f32x4*)(sg + dv);
                v2u w; w.x = cvt_pk_bf16(O[d][4 * g] * rn * gg[0], O[d][4 * g + 1] * rn * gg[1]); w.y = cvt_pk_bf16(O[d][4 * g + 2] * rn * gg[2], O[d][4 * g + 3] * rn * gg[3]);
                *(GAS v2u*)(orow + dv) = w; }
    }
    LDS_WAIT(); __syncthreads();
}
#ifndef NEU_STAGES
#define NEU_STAGES 2
#endif
namespace rw {
constexpr int SLOT = 8192;
constexpr int IM_QH = 0, IM_RH = 1, IM_KT = 2, IM_BT = 3, IM_KTT = 4, IM_BTT = 5, IM_VT = 6, IM_S0 = 7, IM_RHS = 7, IM_ABQ = 8, IM_ABQT = 9, IM_AKQ = 10, IM_UT = 10, IM_AKR = 11, IM_ABR = 12,
              IM_TA = 13, IM_TB = 14, IM_PA = 0, IM_PB = 2, IM_TW = 12, IM_AL = 6;
constexpr int OFF_YC = 13 * SLOT, OFF_LW = 8 * SLOT, OFF_LA = 10 * SLOT, OFF_MISC = 15 * SLOT;
enum Mask { M_NONE = 0, M_LT = 1, M_LE = 2, M_GT = 3 };
__device__ __forceinline__ f32x16 zero16() { f32x16 z;
#pragma unroll
    for (int i = 0; i < 16; ++i) z[i] = 0.f; return z; }
__device__ __forceinline__ f32x16 mm_tile(const LAS unsigned char* X, int xr0, const LAS unsigned char* Y, int yr0, f32x16 acc, int l31, int hh) {
    bf16x8 af[4], bf_[4];
#pragma unroll
    for (int s = 0; s < 4; ++s) { af[s] = *(const LAS bf16x8*)(X + swz(xr0 + l31, 2 * s + hh)); bf_[s] = *(const LAS bf16x8*)(Y + swz(yr0 + l31, 2 * s + hh)); }
    asm volatile("s_waitcnt lgkmcnt(0)" : "+v"(af[0]), "+v"(af[1]), "+v"(af[2]), "+v"(af[3]), "+v"(bf_[0]), "+v"(bf_[1]), "+v"(bf_[2]), "+v"(bf_[3]));
#pragma unroll
    for (int s = 0; s < 4; ++s) acc = MFMA32(af[s], bf_[s], acc);
    return acc;
}
template <int MODE> __device__ __forceinline__ void store_T(LAS unsigned char* img, const f32x16& d, int r0, int c0, int l31, int hh) {
    const int c = c0 + l31;
#pragma unroll
    for (int g = 0; g < 4; ++g) { float v[4];
#pragma unroll
        for (int j = 0; j < 4; ++j) { const int r = r0 + 8 * g + 4 * hh + j; const bool keep = MODE == M_NONE ? true : MODE == M_LT ? (r < c) : MODE == M_LE ? (r <= c) : (c < r); v[j] = keep ? d[4 * g + j] : 0.f; }
        v2u w; w.x = cvt_pk_bf16(v[0], v[1]); w.y = cvt_pk_bf16(v[2], v[3]);
        *(LAS v2u*)(img + swz(c, (r0 >> 3) + g) + 8 * hh) = w; }
}
__device__ __forceinline__ f32x16 load_T(const LAS unsigned char* img, int r0, int c0, int l31, int hh) {
    f32x16 d; const int c = c0 + l31;
#pragma unroll
    for (int g = 0; g < 4; ++g) { const v2u w = *(const LAS v2u*)(img + swz(c, (r0 >> 3) + g) + 8 * hh); d[4 * g] = bflo(w.x); d[4 * g + 1] = bfhi(w.x); d[4 * g + 2] = bflo(w.y); d[4 * g + 3] = bfhi(w.y); }
    return d;
}
__device__ __forceinline__ void put16(LAS unsigned char* img, int row, int col, float v) { *(LAS unsigned short*)(img + swz(row, col >> 3) + (col & 7) * 2) = (unsigned short)(cvt_pk_bf16(v, 0.f) & 0xffffu); }
}

__device__ __forceinline__ unsigned bperm_u(int addr4, unsigned v) { return (unsigned)__builtin_amdgcn_ds_bpermute(addr4, (int)v); }
__device__ __forceinline__ float bperm_f(int addr4, float v) { return __builtin_bit_cast(float, __builtin_amdgcn_ds_bpermute(addr4, __builtin_bit_cast(int, v))); }
struct MixRaw { v4u w0, we; };
__device__ __forceinline__ void mix_load(const bf16* gbase, unsigned toff, unsigned eoff, bool edge, MixRaw& r) {
    const v4u z = {0u, 0u, 0u, 0u};
    r.w0 = *(const GAS v4u*)((const GAS char*)gbase + toff);
    r.we = edge ? *(const GAS v4u*)((const GAS char*)gbase + eoff) : z;
}
#define MIX_OFFS(t_, toff_, eoff_, edge_) const unsigned toff_ = ((unsigned)(t_) * INCP + fc) * 2u; \
    const int te_##toff_ = (lane < 8) ? (dir ? (t_) + 1 : (t_) - 1) : (dir ? (t_) - 1 : (t_) + 1);     \
    const bool edge_ = (lane < 8 || lane >= 56) && te_##toff_ >= 0 && te_##toff_ < SEQ; const unsigned eoff_ = ((unsigned)te_##toff_ * INCP + fc) * 2u
__device__ __forceinline__ void mix_compute(const MixRaw& r, int lane, const LAS float* mul, float (&x)[8]) {
    const f32x4 m0 = *(const LAS f32x4*)mul, m1 = *(const LAS f32x4*)(mul + 4);
    v4u wa, wb;
    const int up4 = ((lane - 8) & 63) << 2, dn4 = ((lane + 8) & 63) << 2;
    wa.x = bperm_u(up4, r.w0.x); wa.y = bperm_u(up4, r.w0.y); wa.z = bperm_u(up4, r.w0.z); wa.w = bperm_u(up4, r.w0.w);
    wb.x = bperm_u(dn4, r.w0.x); wb.y = bperm_u(dn4, r.w0.y); wb.z = bperm_u(dn4, r.w0.z); wb.w = bperm_u(dn4, r.w0.w);
    if (lane < 8) wa = r.we;
    if (lane >= 56) wb = r.we;
    float u0[8], um[8], up[8]; unpack8(r.w0, u0); unpack8(wa, um); unpack8(wb, up);
#pragma unroll
    for (int j = 0; j < 8; ++j) { const float mj = j < 4 ? m0[j] : m1[j - 4]; x[j] = u0[j] + mj * (0.5f * (um[j] + up[j]) - u0[j]); }
}
__device__ __forceinline__ void p3_scan_unit_chunked(const Args& a, const Ctx& F, int unit) {
    using namespace rw;
    unsigned char* ws = a.ws;
    int wave_ = F.wave; asm volatile("" : "+s"(wave_)); const int tid_ = wave_ * 64 + fresh_lane();
    const int dir = unit >> 7, b = (unit >> 3) & 15, h = unit & 7, tid = tid_, lane = tid & 63, wave = wave_, l31 = lane & 31, hh = lane >> 5;
    const bf16* Ub = (const bf16*)(ws + WS_U) + (size_t)b * SEQ * INCP;
    bf16* Y = (bf16*)(ws + WS_Y) + ((size_t)dir * MT + (size_t)b * SEQ) * 512 + h * 64;
    float* BON = (float*)(ws + WS_BON) + ((size_t)dir * MT + (size_t)b * SEQ) * 8 + h;
    LAS unsigned char* L = F.lds + RING_OFF;
#define IMG(s) (L + (s) * SLOT)
    LAS float* YC = (LAS float*)(L + OFF_YC); LAS float* LW = (LAS float*)(L + OFF_LW); LAS float* LA = (LAS float*)(L + OFF_LA);
    LAS float* WLAST = (LAS float*)(L + OFF_MISC); LAS float* WTOT = (LAS float*)(L + OFF_MISC + 256);
    const float* mu = a.in[I_MU];
    const int mat = wave >> 2, ti = (wave >> 1) & 1, ci = wave & 1;
    const bf16* LWp = (const bf16*)(ws + (mat ? WS_LA2 : WS_LW2)) + ((size_t)dir * 512 + h * 64 + 32 * ci + l31) * 64 + 8 * hh;
    const float c0 = (mat ? a.in[I_A0] : a.in[I_W0])[dir * 512 + h * 64 + 32 * ci + l31];
    const int fi = tid >> 3, c8 = tid & 7, fc = c8 * 8;
    const int w4 = wave & 3, tb = w4 >> 1, vb = w4 & 1;
    f32x16 acc_s = zero16();
    for (int i = tid; i < SLOT / 16; i += NTHR) *(LAS v4u*)(IMG(IM_S0) + i * 16) = (v4u){0u, 0u, 0u, 0u};
    LAS float* MUL = (LAS float*)(L + OFF_MISC + 2560);
    const int gcol0 = C_RR + h * 64, gcol1 = C_RK + h * 64, gcol2 = C_RV + h * 64, gcol3 = C_WL + dir * 64, gcol4 = C_AL + dir * 64;
    if (tid < 320) { const int g = tid >> 6, cc = tid & 63; MUL[tid] = mu[(g == 0 ? gcol0 : g == 1 ? gcol1 : g == 2 ? gcol2 : g == 3 ? gcol3 : gcol4) - C_RW + cc]; }
    else if (tid < 512) { const int g = (tid - 320) >> 6, cc = tid & 63; MUL[tid] = (g == 0 ? a.in[I_KK] : g == 1 ? a.in[I_KA] : a.in[I_RK])[h * 64 + cc]; }
    LAS unsigned char* LORAB = F.lds + TAB_OFF + (mat * 2 + ci) * 4096 + lane * 16;
    if (ti == 0) {
#pragma unroll
        for (int ks = 0; ks < 4; ++ks) *(LAS bf16x8*)(LORAB + ks * 1024) = *(const GAS bf16x8*)(LWp + 16 * ks); }
    MixRaw R0, R1, R2;
    MixRaw R3, R4;
    const bf16* G0 = Ub + gcol0; const bf16* G1 = Ub + gcol1; const bf16* G2 = Ub + gcol2; const bf16* G3 = Ub + gcol3; const bf16* G4 = Ub + gcol4;
    { const int t0 = dir ? (SEQ - 1 - fi) : fi; MIX_OFFS(t0, to, eo, ed); mix_load(G0, to, eo, ed, R0); mix_load(G1, to, eo, ed, R1); mix_load(G2, to, eo, ed, R2); mix_load(G3, to, eo, ed, R3); mix_load(G4, to, eo, ed, R4); }
    WG_BAR();
    for (int chn = 0; chn < SEQ / 64; ++chn) {
        const int sidx = chn * 64 + fi, t = dir ? (SEQ - 1 - sidx) : sidx;
        float r8[8], k8[8], v8[8];
        mix_compute(R0, lane, MUL + fc, r8); mix_compute(R1, lane, MUL + 64 + fc, k8); mix_compute(R2, lane, MUL + 128 + fc, v8);
        { float x[8]; mix_compute(R3, lane, MUL + 192 + fc, x);
#pragma unroll
          for (int j = 0; j < 8; ++j) x[j] = 1.0f - 2.0f * frcp(1.0f + fexp2(2.0f * LOG2E * x[j]));
          *(LAS v4u*)(IMG(IM_TW) + swz(fi, c8)) = pack8(x);
          mix_compute(R4, lane, MUL + 256 + fc, x); *(LAS v4u*)(IMG(IM_AL) + swz(fi, c8)) = pack8(x); }
        if (chn + 1 < SEQ / 64) { const int s1 = (chn + 1) * 64 + fi, t1 = dir ? (SEQ - 1 - s1) : s1;
            MIX_OFFS(t1, to, eo, ed); mix_load(G0, to, eo, ed, R0); mix_load(G1, to, eo, ed, R1); mix_load(G2, to, eo, ed, R2); }
        WG_BAR();
        { f32x16 acc = zero16();
#pragma unroll
          for (int ks = 0; ks < 4; ++ks) { const bf16x8 af = *(const LAS bf16x8*)(IMG(mat ? IM_AL : IM_TW) + swz(32 * ti + l31, 2 * ks + hh)); const bf16x8 bq = *(const LAS bf16x8*)(LORAB + ks * 1024); acc = MFMA32(af, bq, acc); }
          LAS float* dst = mat ? LA : LW;
#pragma unroll
          for (int r = 0; r < 16; ++r) dst[(32 * ti + (r & 3) + 8 * (r >> 2) + 4 * hh) * 64 + 32 * ci + l31] = acc[r] + c0; }
        WG_BAR();
        float lw2[8], av[8], kkv[8], kd[8], bb[8];
        { const f32x4 w0 = *(LAS f32x4*)(LW + fi * 64 + fc), w1 = *(LAS f32x4*)(LW + fi * 64 + fc + 4), a0 = *(LAS f32x4*)(LA + fi * 64 + fc), a1 = *(LAS f32x4*)(LA + fi * 64 + fc + 4);
          float ssq = 0.f, bon = 0.f;
#pragma unroll
          for (int j = 0; j < 8; ++j) { const float wl = j < 4 ? w0[j] : w1[j - 4], al = j < 4 ? a0[j] : a1[j - 4];
              lw2[j] = -0.60653065971f * LOG2E * fast_sigmoid(wl); av[j] = fast_sigmoid(al);
              kkv[j] = k8[j] * MUL[320 + fc + j]; ssq += kkv[j] * kkv[j]; kd[j] = k8[j] * (1.0f + (av[j] - 1.0f) * MUL[384 + fc + j]); bon += r8[j] * kd[j] * MUL[448 + fc + j]; }
          ssq = sum8(ssq); bon = sum8(bon);
          const float inv = 1.0f / fmaxf(sqrtf(ssq), 1e-12f);
#pragma unroll
          for (int j = 0; j < 8; ++j) { kkv[j] *= inv; bb[j] = kkv[j] * av[j]; }
          if (c8 == 0) BON[(size_t)t * 8] = bon; }
        float cum[8];
#pragma unroll
        for (int j = 0; j < 8; ++j) { float x = lw2[j]; float y = bperm_f(((lane - 8) & 63) << 2, x); if (lane >= 8) x += y; y = bperm_f(((lane - 16) & 63) << 2, x); if (lane >= 16) x += y; y = bperm_f(((lane - 32) & 63) << 2, x); if (lane >= 32) x += y; cum[j] = x; }
        if (lane >= 56) {
#pragma unroll
            for (int j = 0; j < 8; ++j) WTOT[wave * 64 + fc + j] = cum[j]; }
        WG_BAR();
#pragma unroll 1
        for (int w = 0; w < wave; ++w) { const f32x4 t0 = *(LAS f32x4*)(WTOT + w * 64 + fc), t1 = *(LAS f32x4*)(WTOT + w * 64 + fc + 4);
#pragma unroll
            for (int j = 0; j < 4; ++j) { cum[j] += t0[j]; cum[4 + j] += t1[j]; } }
        { float qh[8], rh[8], kt[8], bt[8];
#pragma unroll
          for (int j = 0; j < 8; ++j) { const float W = fexp2(cum[j]), Wm = fexp2(cum[j] - lw2[j]), Wi = fexp2(-cum[j]);
              qh[j] = kkv[j] * Wm; rh[j] = r8[j] * W; kt[j] = kd[j] * Wi; bt[j] = bb[j] * Wi;
              if (fi == 63) WLAST[fc + j] = W; }
          *(LAS v4u*)(IMG(IM_QH) + swz(fi, c8)) = pack8(qh); *(LAS v4u*)(IMG(IM_RH) + swz(fi, c8)) = pack8(rh);
          *(LAS v4u*)(IMG(IM_KT) + swz(fi, c8)) = pack8(kt); *(LAS v4u*)(IMG(IM_BT) + swz(fi, c8)) = pack8(bt);
#pragma unroll
          for (int j = 0; j < 8; ++j) { put16(IMG(IM_KTT), fc + j, fi, kt[j]); put16(IMG(IM_BTT), fc + j, fi, bt[j]); put16(IMG(IM_VT), fc + j, fi, v8[j]); } }
        WG_BAR();
        f32x16 acc_t;
        acc_t = mm_tile(IMG(wave < 4 ? IM_QH : IM_RH), 32 * tb, IMG(IM_S0), 32 * vb, zero16(), l31, hh);
#pragma unroll 1
        for (int tt = wave; tt < 20; tt += 8) { const int p = tt >> 2, rb = (tt >> 1) & 1, cb = tt & 1;
            if (p == 4 ? (rb < cb) : (rb > cb)) {
                const int im = p == 0 ? IM_AKQ : p == 1 ? IM_ABQ : p == 2 ? IM_AKR : p == 3 ? IM_ABR : IM_ABQT;
#pragma unroll
                for (int g = 0; g < 4; ++g) *(LAS v2u*)(IMG(im) + swz(32 * cb + l31, 4 * rb + g) + 8 * hh) = (v2u){0u, 0u};
                if (p == 1) {
#pragma unroll
                    for (int g = 0; g < 4; ++g) *(LAS v2u*)(IMG(IM_TA) + swz(32 * cb + l31, 4 * rb + g) + 8 * hh) = (v2u){0u, 0u}; }
                continue; }
            const int xs = (p == 0 || p == 2) ? IM_KT : (p == 4 ? IM_QH : IM_BT), ys = (p == 0 || p == 1) ? IM_QH : (p == 4 ? IM_BT : IM_RH);
            const f32x16 d = mm_tile(IMG(xs), 32 * rb, IMG(ys), 32 * cb, zero16(), l31, hh);
            if (p == 0) store_T<M_LT>(IMG(IM_AKQ), d, 32 * rb, 32 * cb, l31, hh);
            else if (p == 1) { store_T<M_LT>(IMG(IM_ABQ), d, 32 * rb, 32 * cb, l31, hh);
                f32x16 t1;
#pragma unroll
                for (int q = 0; q < 16; ++q) { const int r = 32 * rb + (q & 3) + 8 * (q >> 2) + 4 * hh, c = 32 * cb + l31; t1[q] = (r == c ? 1.0f : 0.f) - (r < c ? d[q] : 0.f); }
                store_T<M_NONE>(IMG(IM_TA), t1, 32 * rb, 32 * cb, l31, hh); }
            else if (p == 2) store_T<M_LE>(IMG(IM_AKR), d, 32 * rb, 32 * cb, l31, hh);
            else if (p == 3) store_T<M_LE>(IMG(IM_ABR), d, 32 * rb, 32 * cb, l31, hh);
            else store_T<M_GT>(IMG(IM_ABQT), d, 32 * rb, 32 * cb, l31, hh); }
        WG_BAR();
        if (wave < 4) { acc_t = mm_tile(IMG(IM_AKQ), 32 * tb, IMG(IM_VT), 32 * vb, acc_t, l31, hh); store_T<M_NONE>(IMG(IM_RHS), acc_t, 32 * tb, 32 * vb, l31, hh); }
        else {
#pragma unroll 1
            for (int q = 0; q < 2; ++q) { const int tt = 2 * w4 + q, tr = (tt >> 1) & 1, rb = (tt >> 2), cb = tt & 1;
                const f32x16 d = mm_tile(IMG(tr ? IM_ABQ : IM_ABQT), 32 * rb, IMG(tr ? IM_ABQT : IM_ABQ), 32 * cb, zero16(), l31, hh);
                store_T<M_NONE>(IMG(IM_PA + tr), d, 32 * rb, 32 * cb, l31, hh); } }
        WG_BAR();
        if (wave < 4) { f32x16 d = load_T(IMG(IM_TA), 32 * tb, 32 * vb, l31, hh);
            d = mm_tile(IMG(IM_PA + 1), 32 * tb, IMG(IM_TA), 32 * vb, d, l31, hh);
            store_T<M_NONE>(IMG(IM_TB), d, 32 * tb, 32 * vb, l31, hh); }
        else { f32x16 d = mm_tile(IMG(IM_PA + 1), 32 * tb, IMG(IM_PA), 32 * vb, zero16(), l31, hh);
            store_T<M_NONE>(IMG(IM_PB), d, 32 * tb, 32 * vb, l31, hh);
            d = mm_tile(IMG(IM_TA), 32 * tb, IMG(IM_RHS), 32 * vb, zero16(), l31, hh);
            store_T<M_NONE>(IMG(IM_ABQ), d, 32 * tb, 32 * vb, l31, hh); }
        WG_BAR();
        if (chn + 1 < SEQ / 64) { const int s1 = (chn + 1) * 64 + fi, t1 = dir ? (SEQ - 1 - s1) : s1; MIX_OFFS(t1, to, eo, ed); mix_load(G3, to, eo, ed, R3); mix_load(G4, to, eo, ed, R4); }
        if (wave < 4) { f32x16 d = mm_tile(IMG(IM_TB), 32 * tb, IMG(IM_RHS), 32 * vb, zero16(), l31, hh); d = mm_tile(IMG(IM_PB), 32 * tb, IMG(IM_ABQ), 32 * vb, d, l31, hh); store_T<M_NONE>(IMG(IM_UT), d, 32 * tb, 32 * vb, l31, hh); }
        WG_BAR();
        if (wave >= 4) { acc_t = mm_tile(IMG(IM_AKR), 32 * tb, IMG(IM_VT), 32 * vb, acc_t, l31, hh);
            const f32x16 m = mm_tile(IMG(IM_ABR), 32 * tb, IMG(IM_UT), 32 * vb, zero16(), l31, hh);
#pragma unroll
            for (int q = 0; q < 16; ++q) YC[(32 * tb + (q & 3) + 8 * (q >> 2) + 4 * hh) * 64 + 32 * vb + l31] = acc_t[q] - m[q]; }
        else { acc_s = mm_tile(IMG(IM_KTT), 32 * tb, IMG(IM_VT), 32 * vb, acc_s, l31, hh);
            const f32x16 m = mm_tile(IMG(IM_BTT), 32 * tb, IMG(IM_UT), 32 * vb, zero16(), l31, hh);
#pragma unroll
            for (int q = 0; q < 16; ++q) acc_s[q] = (acc_s[q] - m[q]) * WLAST[32 * tb + (q & 3) + 8 * (q >> 2) + 4 * hh]; }
        WG_BAR();
        if (wave < 4) store_T<M_NONE>(IMG(IM_S0), acc_s, 32 * tb, 32 * vb, l31, hh);
        { const f32x4 y0 = *(LAS f32x4*)(YC + fi * 64 + fc), y1 = *(LAS f32x4*)(YC + fi * 64 + fc + 4);
          v4u w; w.x = cvt_pk_bf16(y0[0], y0[1]); w.y = cvt_pk_bf16(y0[2], y0[3]); w.z = cvt_pk_bf16(y1[0], y1[1]); w.w = cvt_pk_bf16(y1[2], y1[3]);
          *(GAS v4u*)(Y + (size_t)t * 512 + fc) = w; }
    }
    WG_BAR();
#undef IMG
}
__device__ __forceinline__ void p4_unit(const Args& a, const Ctx& F, int unit) {
    unsigned char* ws = a.ws; const int tid = F.tid, lane = F.lane, wave = F.wave, l31 = lane & 31, hh = lane >> 5;
    const int m0 = unit * 32, b = m0 / SEQ, s0 = m0 % SEQ;
    const bf16* Ub = (const bf16*)(ws + WS_U) + (size_t)b * SEQ * INCP;
    LAS bf16* AS = (LAS bf16*)(F.lds + RING_OFF);
    LAS float* GS = (LAS float*)(F.lds + RING_OFF + 16384);
    const float* mu = a.in[I_MU];
    for (int it = tid; it < 640; it += NTHR) { const int tok = it / 20, g = it % 20; float x[8]; mix8(Ub, s0 + tok, C_GL + 8 * g, mu, x);
#pragma unroll
        for (int j = 0; j < 8; ++j) x[j] = fast_sigmoid(x[j]);
        *(LAS v4u*)(AS + tok * 168 + 8 * g) = pack8(x); }
    LDS_WAIT(); __syncthreads();
    const bf16* G2 = (const bf16*)(ws + WS_LG2);
#pragma unroll
    for (int cc = 0; cc < 2; ++cc) { const int ct = 2 * wave + cc; f32x16 acc;
#pragma unroll
        for (int i = 0; i < 16; ++i) acc[i] = 0.f;
#pragma unroll
        for (int ks = 0; ks < 10; ++ks) { const bf16x8 af = *(const LAS bf16x8*)(AS + l31 * 168 + 16 * ks + 8 * hh); const bf16x8 bf_ = *(const GAS bf16x8*)(G2 + (size_t)(32 * ct + l31) * 192 + 16 * ks + 8 * hh); acc = MFMA32(af, bf_, acc); }
#pragma unroll
        for (int r = 0; r < 16; ++r) GS[((r & 3) + 8 * (r >> 2) + 4 * hh) * 516 + 32 * ct + l31] = acc[r]; }
    LDS_WAIT(); __syncthreads();
    { const int tok = tid >> 4, sub = tid & 15, head = sub >> 1, ch0 = head * 64 + (sub & 1) * 32, m = m0 + tok, s = s0 + tok;
      const bf16* Yf = (const bf16*)(ws + WS_Y) + (size_t)m * 512 + ch0; const bf16* Yb = Yf + (size_t)MT * 512;
      float y[32]; float sm = 0.f;
#pragma unroll
      for (int q = 0; q < 4; ++q) { float f[8], g[8]; unpack8(*(const GAS v4u*)(Yf + 8 * q), f); unpack8(*(const GAS v4u*)(Yb + 8 * q), g);
#pragma unroll
          for (int j = 0; j < 8; ++j) { y[8 * q + j] = f[j] + g[j]; sm += y[8 * q + j]; } }
      sm += dpp_f<0xB1>(sm); const float mean = sm * (1.f / 64.f); float vs = 0.f;
#pragma unroll
      for (int j = 0; j < 32; ++j) { y[j] -= mean; vs += y[j] * y[j]; }
      vs += dpp_f<0xB1>(vs); const float rstd = 1.0f / sqrtf(vs * (1.f / 64.f) + RW_LN_EPS);
      const float* BF = (const float*)(ws + WS_BON) + (size_t)m * 8 + head; const float bonus = BF[0] + BF[(size_t)MT * 8];
      const float* lg = a.in[I_LNG] + ch0; const float* lb = a.in[I_LNB] + ch0;
      bf16* dst = (bf16*)(ws + WS_MIX) + (size_t)m * DM + 512 + ch0;
#pragma unroll
      for (int q = 0; q < 4; ++q) { float v[8]; mix8(Ub, s, C_RV + ch0 + 8 * q, mu, v); float o[8];
#pragma unroll
          for (int j = 0; j < 8; ++j) { const int cix = 8 * q + j; o[j] = (y[cix] * rstd * lg[cix] + lb[cix] + bonus * v[j]) * GS[tok * 516 + ch0 + cix]; }
          *(GAS v4u*)(dst + 8 * q) = pack8(o); } }
    LDS_WAIT(); __syncthreads();
}

__device__ __forceinline__ void p6_router(const Args& a, const Ctx& F) {
    unsigned char* ws = a.ws; const int lane = F.lane;
    const int gw = F.vcu * NWAVES + F.wave, NGW = F.G * NWAVES;
    const float* gf = a.in[I_GFFN]; const float* wr = a.in[I_WR];
    LAS float* WT = (LAS float*)(F.lds + RING_OFF);
    for (int i = F.tid; i < DM * 16; i += NTHR) WT[(i & 15) * DM + (i >> 4)] = wr[i];
    LDS_WAIT(); __syncthreads();
    const int nit = (MT + 2 * NGW - 1) / (2 * NGW);
    v2u xw[2][4];
#define ROUTER_LOAD(it_) { _Pragma("unroll") for (int r = 0; r < 2; ++r) { const int m_ = min(gw + (2 * (it_) + r) * NGW, MT - 1); \
        const GAS v2u* xr = (const GAS v2u*)((const bf16*)(ws + WS_HB) + (size_t)m_ * DM) + lane; \
        _Pragma("unroll") for (int j = 0; j < 4; ++j) xw[r][j] = xr[64 * j]; } }
    ROUTER_LOAD(0)
    for (int it = 0; it < nit; ++it) {
        f32x4 v[2][4]; float s[2] = {0.f, 0.f};
#pragma unroll
        for (int r = 0; r < 2; ++r) {
#pragma unroll
            for (int j = 0; j < 4; ++j) { const v2u w = xw[r][j]; v[r][j][0] = bflo(w.x); v[r][j][1] = bfhi(w.x); v[r][j][2] = bflo(w.y); v[r][j][3] = bfhi(w.y);
                s[r] += (v[r][j][0] * v[r][j][0] + v[r][j][1] * v[r][j][1]) + (v[r][j][2] * v[r][j][2] + v[r][j][3] * v[r][j][3]); }
        }
        if (it + 1 < nit) ROUTER_LOAD(it + 1)
        float lg[2][16];
#pragma unroll
        for (int r = 0; r < 2; ++r) { const int m = gw + (2 * it + r) * NGW; const bool ok = m < MT;
            const float rstd = 1.0f / sqrtf(wave_sum(s[r]) * (1.f / DM) + NORM_EPS);
            GAS unsigned* o8 = (GAS unsigned*)(ws + WS_HN8 + (size_t)(ok ? m : 0) * DM) + lane;
#pragma unroll
            for (int j = 0; j < 4; ++j) { const f32x4 g = *(const f32x4*)(gf + 4 * lane + 256 * j); v[r][j] = v[r][j] * rstd * g; if (ok) o8[64 * j] = pg8::cvt4_fp8(v[r][j][0], v[r][j][1], v[r][j][2], v[r][j][3]); }
        }
        int woff = 4 * lane; asm volatile("" : "+v"(woff));
#pragma unroll
        for (int e = 0; e < 16; ++e) { float a0 = 0.f, a1 = 0.f;
#pragma unroll
            for (int j = 0; j < 4; ++j) { const f32x4 w = *(const LAS f32x4*)(WT + e * DM + woff + 256 * j);
                a0 += (v[0][j][0] * w[0] + v[0][j][1] * w[1]) + (v[0][j][2] * w[2] + v[0][j][3] * w[3]); a1 += (v[1][j][0] * w[0] + v[1][j][1] * w[1]) + (v[1][j][2] * w[2] + v[1][j][3] * w[3]); }
            asm volatile("" : "+v"(a0), "+v"(a1));
            lg[0][e] = a0; lg[1][e] = a1; }
#pragma unroll
        for (int r = 0; r < 2; ++r) { const int m = gw + (2 * it + r) * NGW;
            float v8[8], v4[4], v2[2], v1;
            { const bool b5 = lane & 32, b4 = lane & 16, b3 = lane & 8, b2 = lane & 4;
#pragma unroll
              for (int j = 0; j < 8; ++j) { const float snd = b5 ? lg[r][j] : lg[r][8 + j], kp = b5 ? lg[r][8 + j] : lg[r][j]; v8[j] = kp + __shfl_xor(snd, 32); }
#pragma unroll
              for (int j = 0; j < 4; ++j) { const float snd = b4 ? v8[j] : v8[4 + j], kp = b4 ? v8[4 + j] : v8[j]; v4[j] = kp + __shfl_xor(snd, 16); }
#pragma unroll
              for (int j = 0; j < 2; ++j) { const float snd = b3 ? v4[j] : v4[2 + j], kp = b3 ? v4[2 + j] : v4[j]; v2[j] = kp + __shfl_xor(snd, 8); }
              { const float snd = b2 ? v2[0] : v2[1], kp = b2 ? v2[1] : v2[0]; v1 = kp + __shfl_xor(snd, 4); }
              v1 += __shfl_xor(v1, 2); v1 += __shfl_xor(v1, 1); }
            float mx = v1;
            mx = fmaxf(mx, __shfl_xor(mx, 32)); mx = fmaxf(mx, __shfl_xor(mx, 16)); mx = fmaxf(mx, __shfl_xor(mx, 8)); mx = fmaxf(mx, __shfl_xor(mx, 4));
            const float ex = fexp2((v1 - mx) * LOG2E);
            float den = ex; den += __shfl_xor(den, 32); den += __shfl_xor(den, 16); den += __shfl_xor(den, 8); den += __shfl_xor(den, 4);
            if (m < MT && (lane & 3) == 0) ((float*)(ws + WS_AFF))[((size_t)(m / SEQ) * 16 + (lane >> 2)) * SEQ + (m % SEQ)] = ex / den; }
    }
#undef ROUTER_LOAD
    { const int grp = lane >> 4, gl = lane & 15;
      for (int m0 = 4 * gw; m0 < MT; m0 += 4 * NGW) { const int m = m0 + grp;
          const GAS v4u* pr = (const GAS v4u*)((const bf16*)(ws + WS_PE) + (size_t)m * DM) + gl; v4u pw[8]; float ps = 0.f;
#pragma unroll
          for (int i = 0; i < 8; ++i) pw[i] = pr[16 * i];
#pragma unroll
          for (int i = 0; i < 8; ++i) { float t[8]; unpack8(pw[i], t);
#pragma unroll
              for (int j = 0; j < 8; ++j) ps += t[j] * t[j]; }
          ps = sum8(ps); ps += dpp_f<0x140>(ps);
          if (gl == 0) ((float*)(ws + WS_PERS))[m] = 1.0f / sqrtf(ps * (1.f / DM) + NORM_EPS); } }
    LDS_WAIT(); __syncthreads();
}

__device__ __forceinline__ void p7_topk_unit(const Args& a, const Ctx& F, int unit) {
    unsigned char* ws = a.ws; const int tid = F.tid, lane = F.lane, wave = F.wave;
    const int b = unit >> 4, e = unit & 15;
    LAS unsigned* hist = (LAS unsigned*)(F.lds + RING_OFF);
    LAS unsigned* ctl = hist + 256;
    LAS unsigned* wtot = hist + 320;
    const float* aff = (const float*)(ws + WS_AFF) + ((size_t)b * 16 + e) * SEQ;
    const f32x4 av = *(const GAS f32x4*)(aff + 4 * tid);
    unsigned key[4];
#pragma unroll
    for (int j = 0; j < 4; ++j) key[j] = __float_as_uint(av[j]);
    unsigned prefix = 0u, mask = 0u, krem = CAP;
#pragma unroll 1
    for (int pass = 3; pass >= 0; --pass) { const int sh = 8 * pass;
        if (tid < 256) hist[tid] = 0u;
        LDS_WAIT(); __syncthreads();
#pragma unroll
        for (int j = 0; j < 4; ++j) if ((key[j] & mask) == prefix) atomicAdd((unsigned*)&hist[(key[j] >> sh) & 255u], 1u);
        LDS_WAIT(); __syncthreads();
        if (wave == 0) {
            const unsigned h0 = hist[4 * lane], h1 = hist[4 * lane + 1], h2 = hist[4 * lane + 2], h3 = hist[4 * lane + 3];
            const unsigned tot = h0 + h1 + h2 + h3; unsigned suf = tot;
#pragma unroll
            for (int o = 1; o < 64; o <<= 1) { const unsigned t = __shfl_down(suf, o); if (lane + o < 64) suf += t; }
            const unsigned above = suf - tot;
            const unsigned g3 = above, g2 = above + h3, g1 = g2 + h2, g0 = g1 + h1;
            if (g3 < krem && krem <= g3 + h3) { ctl[0] = 4 * lane + 3; ctl[1] = krem - g3; }
            else if (g2 < krem && krem <= g2 + h2) { ctl[0] = 4 * lane + 2; ctl[1] = krem - g2; }
            else if (g1 < krem && krem <= g1 + h1) { ctl[0] = 4 * lane + 1; ctl[1] = krem - g1; }
            else if (g0 < krem && krem <= g0 + h0) { ctl[0] = 4 * lane + 0; ctl[1] = krem - g0; }
        }
        LDS_WAIT(); __syncthreads();
        prefix |= ctl[0] << sh; mask |= 255u << sh; krem = ctl[1];
        LDS_WAIT(); __syncthreads();
    }
    unsigned ngt = 0, neq = 0;
#pragma unroll
    for (int j = 0; j < 4; ++j) { ngt += key[j] > prefix; neq += key[j] == prefix; }
    unsigned pk = ngt | (neq << 16), inc = pk;
#pragma unroll
    for (int o = 1; o < 64; o <<= 1) { const unsigned t = __shfl_up(inc, o); if (lane >= o) inc += t; }
    if (lane == 63) wtot[wave] = inc;
    LDS_WAIT(); __syncthreads();
    unsigned base = 0, total = 0;
#pragma unroll
    for (int w = 0; w < 8; ++w) { const unsigned t = wtot[w]; if (w < wave) base += t; total += t; }
    unsigned ex = base + inc - pk; unsigned gpre = ex & 0xffffu, epre = ex >> 16; const unsigned cgt = total & 0xffffu;
    int* SEL = (int*)(ws + WS_SEL) + ((size_t)b * SEQ + 4 * tid) * 16 + e;
    int* RM = (int*)(ws + WS_RMAP) + ((size_t)e * NB + b) * CAP;
    float* GT = (float*)(ws + WS_GATE) + ((size_t)e * NB + b) * CAP;
#pragma unroll
    for (int j = 0; j < 4; ++j) { int slot = -1;
        if (key[j] > prefix) { slot = (int)gpre; ++gpre; }
        else if (key[j] == prefix) { if (epre < krem) slot = (int)(cgt + epre); ++epre; }
        SEL[j * 16] = slot;
        if (slot >= 0) { RM[slot] = b * SEQ + 4 * tid + j; GT[slot] = av[j]; } }
    LDS_WAIT(); __syncthreads();
}
__device__ __forceinline__ void moe_combine(const Args& a, const Ctx& F) {
    unsigned char* ws = a.ws; const int lane = F.lane, grp = lane >> 4, gl = lane & 15;
    const int gw = F.vcu * NWAVES + F.wave, NGW = F.G * NWAVES;
    const int* SEL = (const int*)(ws + WS_SEL); const float* gp = a.in[I_GPLE];
    const bf16* YE = (const bf16*)(ws + WS_YE);
    for (int m0 = 4 * gw; m0 < MT; m0 += 4 * NGW) {
        const int m = m0 + grp, b = m / SEQ;
        const int sl = SEL[(size_t)m * 16 + gl];
        const GAS v4u* hr = (const GAS v4u*)((const bf16*)(ws + WS_HB) + (size_t)m * DM) + gl;
        v4u hw[8];
#pragma unroll
        for (int i = 0; i < 8; ++i) hw[i] = hr[16 * i];
        const unsigned long long bal = __ballot(sl >= 0);
        unsigned mask = (unsigned)(bal >> (16 * grp)) & 0xffffu;
        const int cnt = __popc(mask);
        const int maxc = max(max(__builtin_amdgcn_readlane(cnt, 0), __builtin_amdgcn_readlane(cnt, 16)), max(__builtin_amdgcn_readlane(cnt, 32), __builtin_amdgcn_readlane(cnt, 48)));
        float acc[8][8];
#pragma unroll
        for (int i = 0; i < 8; ++i) unpack8(hw[i], acc[i]);
        for (int k = 0; k < maxc; k += 2) {
            const bool has1 = mask != 0u; const int e1 = (__ffs(mask) - 1) & 15; mask &= mask - 1u;
            const bool has2 = mask != 0u; const int e2 = (__ffs(mask) - 1) & 15; mask &= mask - 1u;
            const int s1 = __builtin_amdgcn_ds_bpermute(((grp << 4) + e1) << 2, sl), s2 = __builtin_amdgcn_ds_bpermute(((grp << 4) + e2) << 2, sl);
            const v4u z = {0u, 0u, 0u, 0u}; v4u r1[8], r2[8];
            const GAS v4u* y1 = (const GAS v4u*)(YE + (size_t)((e1 * NB + b) * CAP + (has1 ? s1 : 0)) * DM) + gl;
            const GAS v4u* y2 = (const GAS v4u*)(YE + (size_t)((e2 * NB + b) * CAP + (has2 ? s2 : 0)) * DM) + gl;
#pragma unroll
            for (int i = 0; i < 8; ++i) r1[i] = has1 ? y1[16 * i] : z;
#pragma unroll
            for (int i = 0; i < 8; ++i) r2[i] = has2 ? y2[16 * i] : z;
#pragma unroll
            for (int i = 0; i < 8; ++i) { float t[8]; unpack8(r1[i], t);
#pragma unroll
                for (int j = 0; j < 8; ++j) acc[i][j] += t[j]; }
#pragma unroll
            for (int i = 0; i < 8; ++i) { float t[8]; unpack8(r2[i], t);
#pragma unroll
                for (int j = 0; j < 8; ++j) acc[i][j] += t[j]; }
        }
        GAS v4u* h2r = (GAS v4u*)((bf16*)(ws + WS_H2B) + (size_t)m * DM) + gl;
        float s = 0.f;
#pragma unroll
        for (int i = 0; i < 8; ++i) { h2r[16 * i] = pack8(acc[i]);
#pragma unroll
            for (int j = 0; j < 8; ++j) s += acc[i][j] * acc[i][j]; }
        s = sum8(s); s += dpp_f<0x140>(s);
        const float rstd = 1.0f / sqrtf(s * (1.f / DM) + NORM_EPS);
        GAS v2u* o8 = (GAS v2u*)(ws + WS_HN2 + (size_t)m * DM) + gl;
#pragma unroll
        for (int i = 0; i < 8; ++i) { const f32x4 g0 = *(const f32x4*)(gp + 8 * (gl + 16 * i)), g1 = *(const f32x4*)(gp + 8 * (gl + 16 * i) + 4);
            v2u w; w.x = pg8::cvt4_fp8(acc[i][0] * rstd * g0[0], acc[i][1] * rstd * g0[1], acc[i][2] * rstd * g0[2], acc[i][3] * rstd * g0[3]);
            w.y = pg8::cvt4_fp8(acc[i][4] * rstd * g1[0], acc[i][5] * rstd * g1[1], acc[i][6] * rstd * g1[2], acc[i][7] * rstd * g1[3]); o8[16 * i] = w; }
    }
}
constexpr int NPHASE = 10;
__global__ void __launch_bounds__(NTHR, 2) fwd_kernel(Args args) {
    extern __shared__ __attribute__((aligned(16))) unsigned char lds[];
    Ctx F; F.lds = (LAS unsigned char*)lds; F.tid = threadIdx.x; F.lane = F.tid & 63; F.wave = __builtin_amdgcn_readfirstlane(F.tid >> 6);
    F.G = gridDim.x; { const int bx = blockIdx.x; F.vcu = (F.G % 8 == 0) ? (bx % 8) * (F.G / 8) + bx / 8 : bx; }
    unsigned char* ws = args.ws;
    for (int u = F.tid; u < (LDS_BYTES - LDSCTL_OFF) / 4; u += NTHR) ((LAS unsigned*)(F.lds + LDSCTL_OFF))[u] = 0u;
    __syncthreads();
    const int lo = args.ph_lo, hi = args.ph_hi;
    XcdBarrier bar; bar.bar = (unsigned*)(ws + WS_CTL) + CW_BAR + args.li * XCD_BAR_WORDS; bar.x = 0; bar.st = nullptr; bar.w = F.wave;
    if (hi - lo > 1) bar = xcd_barrier_post((unsigned*)(ws + WS_CTL) + CW_BAR + args.li * XCD_BAR_WORDS, (volatile LAS unsigned*)(F.lds + MISC_OFF) + 8, F.wave);
#define IN(k) (lo <= (k) && (k) < hi && ((F.lane = fresh_lane()), (F.tid = F.wave * 64 + F.lane), true))
#ifdef TPROBE
    long long tp_a = 0; if (TPROBE == 0) tp_a = wall_clock64();
#define SEAM(k) do { if (IN(k) && IN((k) + 1)) xcd_barrier(bar); if ((k) == TPROBE - 1) tp_a = wall_clock64(); \
        if ((k) == TPROBE && cblk == 0 && F.tid == 0) { const float us = (float)(wall_clock64() - tp_a) * 0.01f; __hip_atomic_store((float*)(ws + WS_CTL) + 262000, 0.05f + us * 0.001f, __ATOMIC_RELAXED, __HIP_MEMORY_SCOPE_AGENT); } } while (0)
#else
#define SEAM(k) do { if (IN(k) && IN((k) + 1)) xcd_barrier(bar); } while (0)
#endif
    LAS unsigned char* ring = F.lds + RING_OFF;
    const int cblk = (int)blockIdx.x;

    if (IN(0)) { p0_prologue(args, F); SEAM(0); }

    if (IN(1)) {
        pg8::Gemm g{(const bf16*)(ws + WS_XN), (const bf16*)(ws + WS_WIN), MT, INCP, DM, 1 << 20, 0}; g.wid = F.wave; pg8::StaticOrder S; S.init(MT, INCP, F.G, cblk);
        pg8::EpiBf16Plain E{(bf16*)(ws + WS_U), INCP};
        const int nconv = (NE * 2048 + F.G * NWAVES - 1) / (F.G * NWAVES), asplit = cblk & 7;
        S.iN = asplit; pg8::gemm_phase<pg8::EpiBf16Plain, pg8::StaticOrder, true, true>(ring, g, S, E);
        conv_stream<0>(args, F, 0, nconv); __syncthreads();
        S.i0 = asplit; S.iN = 1 << 20; pg8::gemm_phase<pg8::EpiBf16Plain, pg8::StaticOrder, true, true>(ring, g, S, E);
        SEAM(1);
    }
    if (IN(2)) {
        p2_attn_prep(args, F);
        for (int u = F.vcu; u < 2 * NB * 8; u += F.G) p3_scan_unit_chunked(args, F, u);
        SEAM(2);
    }
    if (IN(3)) {
        float lam;
        { const float p1 = (F.lane < 64) ? args.in[I_LQ1][F.lane] * args.in[I_LK1][F.lane] : 0.f, p2 = args.in[I_LQ2][F.lane] * args.in[I_LK2][F.lane];
          lam = __expf(wave_sum(p1)) - __expf(wave_sum(p2)) + 0.2f; }
        for (int u = F.vcu; u < NB * 4 * 16; u += F.G) p3_attn_unit(args, F, u, lam);
        for (int u = F.vcu; u < MT / 32; u += F.G) p4_unit(args, F, u);
        SEAM(3);
    }
    if (IN(4)) {
        { pg8::Gemm g{(const bf16*)(ws + WS_MIX), (const bf16*)(ws + WS_WOUT), MT, DM, DM, 1 << 20, 0}; g.wid = F.wave; pg8::StaticOrder S; S.init(MT, DM, F.G, cblk);
          pg8::EpiResBf16 E{args.in[I_X], (bf16*)(ws + WS_HB), DM};
          pg8::gemm_phase<pg8::EpiResBf16, pg8::StaticOrder, true, true>(ring, g, S, E); }
        { pg8::Gemm g{(const bf16*)(ws + WS_PB), (const bf16*)(ws + WS_WPLE), MT, DM, 256, 1 << 20, 0}; g.wid = F.wave; pg8::StaticOrder S; S.init(MT, DM, F.G, cblk);
          pg8::EpiBf16Plain E{(bf16*)(ws + WS_PE), DM};
          pg8::gemm_phase<pg8::EpiBf16Plain, pg8::StaticOrder, true, true>(ring, g, S, E); }
        SEAM(4);
    }
    if (IN(5)) { p6_router(args, F); SEAM(5); }
    if (IN(6)) { for (int u = F.vcu; u < NB * NE; u += F.G) p7_topk_unit(args, F, u); SEAM(6); }
#define MOE_G1(gi) { pg8::Gemm g{(const bf16*)(ws + WS_HN8), (const bf16*)(ws + WS_W13 + (size_t)(gi) * EPG * 4096 * DM), MG, 4096, DM / 2, NB, (size_t)4096 * DM, (const int*)(ws + WS_RMAP) + (size_t)(gi) * MG, TAB_OFF, WSCALE_E8M0}; \
        g.wid = F.wave; pg8::StaticOrder S; S.init(MG, 4096, F.G, cblk); pg8::EpiSwiGLU8 E{ws + WS_HDN + (size_t)(gi) * MG * DFF, DFF}; \
        pg8::gemm_phase<pg8::EpiSwiGLU8, pg8::StaticOrder, true, true, true, true>(ring, g, S, E); }
#define MOE_G2(gi) { pg8::Gemm g{(const bf16*)(ws + WS_HDN + (size_t)(gi) * MG * DFF), (const bf16*)(ws + WS_W2T + (size_t)(gi) * EPG * DM * DFF), MG, DM, DFF / 2, NB, (size_t)DM * DFF, nullptr, 0, WSCALE_E8M0}; \
        g.wid = F.wave; pg8::StaticOrder S; S.init(MG, DM, F.G, cblk); pg8::EpiRowScaleBf16 E{(bf16*)(ws + WS_YE) + (size_t)(gi) * MG * DM, DM, (const float*)(ws + WS_GATE) + (size_t)(gi) * MG}; \
        pg8::gemm_phase<pg8::EpiRowScaleBf16, pg8::StaticOrder, true, true, false, true>(ring, g, S, E); }
    if (IN(7)) {
        const int cpos = (cblk & 7) % 3;
        if (cpos == 0) { conv_stream<1>(args, F, 0, 1 << 20); __syncthreads(); }
        MOE_G1(0)
        if (cpos == 1) { conv_stream<1>(args, F, 0, 1 << 20); __syncthreads(); }
        MOE_G1(1)
        if (cpos == 2) conv_stream<1>(args, F, 0, 1 << 20);
        SEAM(7); }
    if (IN(8)) { MOE_G2(0) MOE_G2(1) SEAM(8); }
#undef MOE_G1
#undef MOE_G2
    if (IN(9)) { moe_combine(args, F); SEAM(9); }
    if (IN(10)) {
        pg8::Gemm g{(const bf16*)(ws + WS_HN2), (const bf16*)(ws + WS_WPG), MT, DM, DM / 2, 1 << 20, 0, nullptr, 0, WSCALE_E8M0}; g.wid = F.wave; pg8::StaticOrder S; S.init(MT, DM, F.G, cblk);
        pg8::EpiPleFinal E{(const bf16*)(ws + WS_H2B), args.out, DM, (const bf16*)(ws + WS_PE), (const float*)(ws + WS_PERS), args.in[I_GPOST]};
#ifdef TPROBE
        E.dbg = 1.0f + __hip_atomic_load((float*)(ws + WS_CTL) + 262000, __ATOMIC_RELAXED, __HIP_MEMORY_SCOPE_AGENT);
#endif
        pg8::gemm_phase<pg8::EpiPleFinal, pg8::StaticOrder, true, true, false, true>(ring, g, S, E);
    }
#undef IN
#undef SEAM
}

#ifndef MK_PER_PHASE
#define MK_PER_PHASE 0
#endif
extern "C" void kernel_launch(void* const* d_in, const int* in_sizes, int n_in, void* d_out, int out_size, void* d_ws, size_t ws_size, hipStream_t stream) {
    static int grid = 0;
    if (grid == 0) {
        if (n_in != N_IN || in_sizes[0] != MT * DM || out_size != MT * DM || ws_size < WS_END) { fprintf(stderr, "kernel_launch: unexpected problem (n_in %d, in0 %d, out %d, ws %zu < %zu): nothing launched\n", n_in, n_in > 0 ? in_sizes[0] : -1, out_size, ws_size, (size_t)WS_END); grid = -1; return; }
        int dev = 0, cus = 0, per_cu = 0;
        if (hipGetDevice(&dev) != hipSuccess || hipDeviceGetAttribute(&cus, hipDeviceAttributeMultiprocessorCount, dev) != hipSuccess) { grid = -1; return; }
        if (hipFuncSetAttribute((const void*)fwd_kernel, hipFuncAttributeMaxDynamicSharedMemorySize, LDS_BYTES) != hipSuccess) { fprintf(stderr, "kernel_launch: hipFuncSetAttribute failed\n"); grid = -1; return; }
        if (hipOccupancyMaxActiveBlocksPerMultiprocessor(&per_cu, (const void*)fwd_kernel, NTHR, LDS_BYTES) != hipSuccess || per_cu < 1) { fprintf(stderr, "kernel_launch: occupancy query says %d blocks per CU\n", per_cu); }
        (void)hipGetLastError();
        grid = cus;
    }
    if (grid < 0) return;
    if (hipMemsetAsync((char*)d_ws + WS_CTL, 0, CTL_ZERO_BYTES, stream) != hipSuccess) return;
    Args a{};
    for (int i = 0; i < N_IN; ++i) a.in[i] = (const float*)d_in[i];
    a.out = (float*)d_out; a.ws = (unsigned char*)d_ws; a.pad = 0;
#if MK_PER_PHASE
#ifndef MK_DUP_PHASE
#define MK_DUP_PHASE -1
#define MK_DUP_N 0
#endif
    for (int p = 0; p <= NPHASE; ++p) for (int rep = 0; rep < 1 + (p == MK_DUP_PHASE ? MK_DUP_N : 0); ++rep) { a.ph_lo = p; a.ph_hi = p + 1; a.li = 0; hipLaunchKernelGGL(fwd_kernel, dim3(grid), dim3(NTHR), LDS_BYTES, stream, a); }
#else
    a.ph_lo = 0; a.ph_hi = NPHASE + 1; a.li = 0;
    hipLaunchKernelGGL(fwd_kernel, dim3(grid), dim3(NTHR), LDS_BYTES, stream, a);
#endif
}
```

```cpp
#include <hip/hip_runtime.h>
#include <cstdio>
#include <cstdint>
namespace pg8 {
#define PG8_LAS __attribute__((address_space(3)))
typedef unsigned short bf16_t;
typedef short bf16x8 __attribute__((ext_vector_type(8)));
typedef float f32x4 __attribute__((ext_vector_type(4)));
typedef float f32x2 __attribute__((ext_vector_type(2)));
typedef unsigned u32x4 __attribute__((ext_vector_type(4)));
typedef unsigned u32x2 __attribute__((ext_vector_type(2)));
typedef __bf16 bf16x2_t __attribute__((ext_vector_type(2)));
typedef int v4i __attribute__((ext_vector_type(4)));
typedef int v8i __attribute__((ext_vector_type(8)));
constexpr int BM = 256, BK = 64, HALF = 128, HTB = HALF * BK * 2, STAGE_BYTES = 8 * HTB, NXCD = 8, WGM = 8;

__host__ __device__ __forceinline__ int lds_byte(int r, int c) { const int st = (r >> 4) * 2 + (c >> 5), rr = r & 15, cc = c & 31, ob = rr * 64 + cc * 2; return st * 1024 + (ob ^ (((ob >> 9) & 1) << 5)); }
__host__ __device__ __forceinline__ void stage_rc(int b, int& R, int& C) { const int st = b / 1024, sb = b % 1024, swz = sb ^ (((sb >> 9) & 1) << 5); R = (st >> 1) * 16 + swz / 64; C = (st & 1) * 32 + (swz % 64) / 2; }
__host__ __device__ __forceinline__ int perm32(int rho) { const int n = rho >> 4, i = rho & 15; return 8 * (i >> 2) + 4 * n + (i & 3); }

struct Unit { int pm, pn; };
struct Gemm { const bf16_t* A; const bf16_t* Bt; int M, N, K; int tpg; size_t gstride; const int* arow = nullptr; int tab_off = 0; int wscale = 0x7f7f7f7f; int wid = 0; };

struct StaticOrder {
    int nM, nN, nwg, G, c, i0, iN;
    __host__ __device__ void init(int M, int N, int G_, int c_) { nM = M / BM; nN = N / BM; nwg = nM * nN; G = G_; c = c_; i0 = 0; iN = 1 << 20; }
    __host__ __device__ bool next(int i, Unit& u) const {
        i += i0; if (i >= iN) return false;
        const long L = (long)i * G + c; if (L >= nwg) return false;
        int wgid = (int)L; { const int q = nwg / NXCD, r = nwg % NXCD, xcd = wgid % NXCD, off = wgid / NXCD; wgid = (xcd < r ? xcd * (q + 1) : r * (q + 1) + (xcd - r) * q) + off; }
        const int nig = WGM * nN, gid = wgid / nig, fm = gid * WGM, gsz = (nM - fm) < WGM ? (nM - fm) : WGM;
        u.pm = fm + ((wgid % nig) % gsz); u.pn = (wgid % nig) / gsz; return true;
    }
    __device__ __forceinline__ void a_ready(const Unit&) const {}
    __device__ __forceinline__ void done(const Unit&) const {}
};

__device__ __forceinline__ unsigned cvt_pk_bf16(float lo, float hi) { f32x2 v = {lo, hi}; bf16x2_t b = __builtin_convertvector(v, bf16x2_t); return __builtin_bit_cast(unsigned, b); }
__device__ __forceinline__ float fast_sigmoid(float x) { return __builtin_amdgcn_rcpf(1.0f + __builtin_amdgcn_exp2f(-1.4426950408889634f * x)); }

struct EpiBf16Plain {
    static constexpr bool PERM = true, AFTER_DRAIN = false;
    bf16_t* O; int ldc;
    __device__ __forceinline__ void operator()(const f32x4 (&acc)[2][2][4][2], const Unit& u, int wr, int wc, int fr, int fq) const {
        const int row0 = u.pm * BM + wr * 64 + fr, col0 = u.pn * BM + wc * 32 + 8 * fq;
#pragma unroll
        for (int ai = 0; ai < 2; ++ai)
#pragma unroll
            for (int m = 0; m < 4; ++m) { bf16_t* rowp = O + (size_t)(row0 + ai * HALF + m * 16) * ldc + col0;
#pragma unroll
                for (int bj = 0; bj < 2; ++bj) { const f32x4 v0 = acc[ai][bj][m][0], v1 = acc[ai][bj][m][1];
                    u32x4 w; w.x = cvt_pk_bf16(v0[0], v0[1]); w.y = cvt_pk_bf16(v0[2], v0[3]); w.z = cvt_pk_bf16(v1[0], v1[1]); w.w = cvt_pk_bf16(v1[2], v1[3]);
                    *(u32x4*)(rowp + bj * HALF) = w; } }
    }
};
struct EpiSwiGLU {
    static constexpr bool PERM = true, AFTER_DRAIN = false;
    bf16_t* O; int ldc;
    __device__ __forceinline__ void operator()(const f32x4 (&acc)[2][2][4][2], const Unit& u, int wr, int wc, int fr, int fq) const {
        const int row0 = u.pm * BM + wr * 64 + fr, col0 = u.pn * HALF + wc * 32 + 8 * fq;
#pragma unroll
        for (int ai = 0; ai < 2; ++ai)
#pragma unroll
            for (int m = 0; m < 4; ++m) { bf16_t* rowp = O + (size_t)(row0 + ai * HALF + m * 16) * ldc + col0;
                float r[8];
#pragma unroll
                for (int n = 0; n < 2; ++n)
#pragma unroll
                    for (int j = 0; j < 4; ++j) { const float a = acc[ai][0][m][n][j], b = acc[ai][1][m][n][j]; r[4 * n + j] = a * fast_sigmoid(a) * b; }
                u32x4 w; w.x = cvt_pk_bf16(r[0], r[1]); w.y = cvt_pk_bf16(r[2], r[3]); w.z = cvt_pk_bf16(r[4], r[5]); w.w = cvt_pk_bf16(r[6], r[7]);
                *(u32x4*)rowp = w; }
    }
};
__device__ __forceinline__ unsigned cvt4_fp8(float a, float b, float c, float d) { int w = 0; w = __builtin_amdgcn_cvt_pk_fp8_f32(a, b, w, false); w = __builtin_amdgcn_cvt_pk_fp8_f32(c, d, w, true); return (unsigned)w; }
struct EpiSwiGLU8 {
    static constexpr bool PERM = true, AFTER_DRAIN = false;
    unsigned char* O; int ldc;
    __device__ __forceinline__ void operator()(const f32x4 (&acc)[2][2][4][2], const Unit& u, int wr, int wc, int fr, int fq) const {
        const int row0 = u.pm * BM + wr * 64 + fr, col0 = u.pn * HALF + wc * 32 + 8 * fq;
#pragma unroll
        for (int ai = 0; ai < 2; ++ai)
#pragma unroll
            for (int m = 0; m < 4; ++m) { unsigned char* rowp = O + (size_t)(row0 + ai * HALF + m * 16) * ldc + col0;
                float r[8];
#pragma unroll
                for (int n = 0; n < 2; ++n)
#pragma unroll
                    for (int j = 0; j < 4; j += 2) {
                        const f32x2 a2 = {acc[ai][0][m][n][j], acc[ai][0][m][n][j + 1]}, b2 = {acc[ai][1][m][n][j], acc[ai][1][m][n][j + 1]};
                        const f32x2 t = a2 * (f32x2){-1.4426950408889634f, -1.4426950408889634f};
                        const f32x2 d = (f32x2){__builtin_amdgcn_exp2f(t[0]), __builtin_amdgcn_exp2f(t[1])} + (f32x2){1.0f, 1.0f};
                        const f32x2 q = (a2 * b2) * (f32x2){__builtin_amdgcn_rcpf(d[0]), __builtin_amdgcn_rcpf(d[1])};
                        r[4 * n + j] = q[0]; r[4 * n + j + 1] = q[1]; }
                u32x2 w; w.x = cvt4_fp8(r[0], r[1], r[2], r[3]); w.y = cvt4_fp8(r[4], r[5], r[6], r[7]);
                *(u32x2*)rowp = w; }
    }
};
struct EpiRowScaleBf16 {
    static constexpr bool PERM = true, AFTER_DRAIN = false;
    bf16_t* O; int ldc; const float* scale;
    __device__ __forceinline__ void operator()(const f32x4 (&acc)[2][2][4][2], const Unit& u, int wr, int wc, int fr, int fq) const {
        const int row0 = u.pm * BM + wr * 64 + fr, col0 = u.pn * BM + wc * 32 + 8 * fq;
#pragma unroll
        for (int ai = 0; ai < 2; ++ai)
#pragma unroll
            for (int m = 0; m < 4; ++m) { const int row = row0 + ai * HALF + m * 16; const float sc = scale[row]; bf16_t* rowp = O + (size_t)row * ldc + col0;
#pragma unroll
                for (int bj = 0; bj < 2; ++bj) { const f32x4 v0 = acc[ai][bj][m][0] * sc, v1 = acc[ai][bj][m][1] * sc;
                    u32x4 w; w.x = cvt_pk_bf16(v0[0], v0[1]); w.y = cvt_pk_bf16(v0[2], v0[3]); w.z = cvt_pk_bf16(v1[0], v1[1]); w.w = cvt_pk_bf16(v1[2], v1[3]);
                    *(u32x4*)(rowp + bj * HALF) = w; } }
    }
};
struct EpiResF32 {
    static constexpr bool PERM = false, AFTER_DRAIN = false;
    const float* base; float* out; int ldc;
    __device__ __forceinline__ void operator()(const f32x4 (&acc)[2][2][4][2], const Unit& u, int wr, int wc, int fr, int fq) const {
        const int row0 = u.pm * BM + wr * 64 + fr, col0 = u.pn * BM + wc * 32 + 4 * fq;
#pragma unroll
        for (int ai = 0; ai < 2; ++ai)
#pragma unroll
            for (int m = 0; m < 4; ++m) { const size_t off = (size_t)(row0 + ai * HALF + m * 16) * ldc + col0;
#pragma unroll
                for (int bj = 0; bj < 2; ++bj)
#pragma unroll
                    for (int n = 0; n < 2; ++n) { const f32x4 bs = *(const f32x4*)(base + off + bj * HALF + n * 16); *(f32x4*)(out + off + bj * HALF + n * 16) = bs + acc[ai][bj][m][n]; } }
    }
};
struct EpiResBf16 {
    static constexpr bool PERM = true, AFTER_DRAIN = false;
    const float* base; bf16_t* out; int ldc;
    __device__ __forceinline__ void operator()(const f32x4 (&acc)[2][2][4][2], const Unit& u, int wr, int wc, int fr, int fq) const {
        const int row0 = u.pm * BM + wr * 64 + fr, col0 = u.pn * BM + wc * 32 + 8 * fq;
        f32x4 bv[2][4];
#define EPI_LD(it_, b_) { const size_t off = (size_t)(row0 + ((it_) >> 2) * HALF + ((it_) & 3) * 16) * ldc + col0; \
            _Pragma("unroll") for (int q = 0; q < 4; ++q) bv[b_][q] = *(const f32x4*)(base + off + (q >> 1) * HALF + (q & 1) * 4); }
        EPI_LD(0, 0)
#pragma unroll
        for (int it = 0; it < 8; ++it) { const int ai = it >> 2, m = it & 3; const size_t off = (size_t)(row0 + ai * HALF + m * 16) * ldc + col0;
            if (it + 1 < 8) EPI_LD(it + 1, (it + 1) & 1)
#pragma unroll
            for (int bj = 0; bj < 2; ++bj) { const f32x4 v0 = bv[it & 1][2 * bj] + acc[ai][bj][m][0], v1 = bv[it & 1][2 * bj + 1] + acc[ai][bj][m][1];
                u32x4 w; w.x = cvt_pk_bf16(v0[0], v0[1]); w.y = cvt_pk_bf16(v0[2], v0[3]); w.z = cvt_pk_bf16(v1[0], v1[1]); w.w = cvt_pk_bf16(v1[2], v1[3]); *(u32x4*)(out + off + bj * HALF) = w; } }
#undef EPI_LD
    }
};
struct EpiPleFinal {
    static constexpr bool PERM = true, AFTER_DRAIN = false;
    const bf16_t* h2; float* out; int ldc; const bf16_t* pe; const float* prs; const float* gp;
#ifdef TPROBE
    float dbg;
#endif
    __device__ __forceinline__ void operator()(const f32x4 (&acc)[2][2][4][2], const Unit& u, int wr, int wc, int fr, int fq) const {
        const int row0 = u.pm * BM + wr * 64 + fr, col0 = u.pn * BM + wc * 32 + 8 * fq;
        f32x4 g4[2][2];
#pragma unroll
        for (int bj = 0; bj < 2; ++bj)
#pragma unroll
            for (int n = 0; n < 2; ++n) g4[bj][n] = *(const f32x4*)(gp + col0 + bj * HALF + n * 4);
#pragma unroll
        for (int ai = 0; ai < 2; ++ai)
#pragma unroll
            for (int m = 0; m < 4; ++m) { const int row = row0 + ai * HALF + m * 16; const size_t off = (size_t)row * ldc + col0; const float rs = prs[row];
#pragma unroll
                for (int bj = 0; bj < 2; ++bj) { const size_t o2 = off + bj * HALF; const u32x4 hw = *(const u32x4*)(h2 + o2); const u32x4 pw = *(const u32x4*)(pe + o2);
                    const unsigned hq[4] = {hw.x, hw.y, hw.z, hw.w}, pq[4] = {pw.x, pw.y, pw.z, pw.w};
#pragma unroll
                    for (int n = 0; n < 2; ++n) { f32x4 hv, e;
                        hv[0] = __uint_as_float(hq[2 * n] << 16); hv[1] = __uint_as_float(hq[2 * n] & 0xffff0000u); hv[2] = __uint_as_float(hq[2 * n + 1] << 16); hv[3] = __uint_as_float(hq[2 * n + 1] & 0xffff0000u);
                        e[0] = __uint_as_float(pq[2 * n] << 16); e[1] = __uint_as_float(pq[2 * n] & 0xffff0000u); e[2] = __uint_as_float(pq[2 * n + 1] << 16); e[3] = __uint_as_float(pq[2 * n + 1] & 0xffff0000u);
                        const f32x4 a = acc[ai][bj][m][n]; f32x4 o;
#pragma unroll
                        for (int j = 0; j < 4; ++j) o[j] = hv[j] + fast_sigmoid(a[j]) * (e[j] * rs * g4[bj][n][j]);
#ifdef TPROBE
                        o *= dbg;
#endif
                        *(f32x4*)(out + o2 + 4 * n) = o; } } }
    }
};
template <class Epi, class Sched, bool ALIGN_EPI = false, bool SP2 = false, bool GATHER = false, bool FP8 = false>
__device__ __forceinline__ void gemm_phase(PG8_LAS unsigned char* lds, const Gemm g, const Sched& S, const Epi& E) {
    int lane_; asm volatile("v_mbcnt_lo_u32_b32 %0, -1, 0\n\tv_mbcnt_hi_u32_b32 %0, -1, %0" : "=v"(lane_));
    const int wid = g.wid, lane = lane_, tid = wid * 64 + lane, wr = wid >> 2, wc = wid & 3, fr = lane & 15, fq = lane >> 4;
    const int K = g.K, nt = K / BK;
    unsigned voffA[2], voffB[2];
#pragma unroll
    for (int i = 0; i < 2; ++i) { int R, C; stage_rc(tid * 16 + i * 8192, R, C); const int Rb = Epi::PERM ? ((R & ~31) + perm32(R & 31)) : R;
        voffA[i] = (unsigned)(R * K + C) * 2u; voffB[i] = (unsigned)(Rb * K + C) * 2u; }
    static_assert(!GATHER || SP2, "gathered A rows: SP2 loop only");
    int gR[2], gC[2];
#pragma unroll
    for (int i = 0; i < 2; ++i) stage_rc(tid * 16 + i * 8192, gR[i], gC[i]);
    unsigned vAc[2][2], vAn[2][2], vS[2][2];
#pragma unroll
    for (int hf = 0; hf < 2; ++hf)
#pragma unroll
        for (int i = 0; i < 2; ++i) { vAc[hf][i] = 0u; vAn[hf][i] = 0u; vS[hf][i] = 0u; }
    const size_t kstep = (size_t)(BK * 2);
    const size_t hstep = (size_t)HALF * K * 2;
    const size_t hstepA = GATHER ? 0 : hstep;
    const size_t tstep = 2 * hstep;
    const unsigned ldsw = (unsigned)wid * 1024u;
    const int aoff = FP8 ? lds_byte(wr * 64 + fr, 16 * (fq & 1)) + (fq >> 1) * 1024 : lds_byte(wr * 64 + fr, fq * 8);
    const int boff = FP8 ? lds_byte(wc * 32 + fr, 16 * (fq & 1)) + (fq >> 1) * 1024 : lds_byte(wc * 32 + fr, fq * 8);

#define PG8_SA(b, h) (((b) * 2 + (h)) * HTB)
#define PG8_SB(b, h) ((4 + (b) * 2 + (h)) * HTB)
#define PG8_STAGE(bufoff, gbase, voff) do { _Pragma("unroll") for (int _i = 0; _i < 2; ++_i) \
        __builtin_amdgcn_global_load_lds((const unsigned*)((const char*)(gbase) + (voff)[_i]), (PG8_LAS unsigned*)(lds + (bufoff) + ldsw + _i * 8192), 16, 0, 0); } while (0)
#define PG8_LD8(p_) __builtin_shufflevector(*(const PG8_LAS v4i*)(p_), *(const PG8_LAS v4i*)((p_) + 16), 0, 1, 2, 3, 4, 5, 6, 7)
#define PG8_LDA(dst, b, h) do { if constexpr (FP8) { _Pragma("unroll") for (int m = 0; m < 4; ++m) dst##8[m] = PG8_LD8(lds + PG8_SA(b, h) + aoff + m * 2048); } \
        else { _Pragma("unroll") for (int m = 0; m < 4; ++m) _Pragma("unroll") for (int k = 0; k < 2; ++k) dst[m][k] = *(const PG8_LAS bf16x8*)(lds + PG8_SA(b, h) + aoff + m * 2048 + k * 1024); } } while (0)
#define PG8_LDB(dst, b, h) do { if constexpr (FP8) { _Pragma("unroll") for (int n = 0; n < 2; ++n) dst##8[n] = PG8_LD8(lds + PG8_SB(b, h) + boff + n * 2048); } \
        else { _Pragma("unroll") for (int n = 0; n < 2; ++n) _Pragma("unroll") for (int k = 0; k < 2; ++k) dst[n][k] = *(const PG8_LAS bf16x8*)(lds + PG8_SB(b, h) + boff + n * 2048 + k * 1024); } } while (0)
#define PG8_MMA(ai, bj, At, Bt) do { __builtin_amdgcn_s_setprio(1); _Pragma("unroll") for (int m = 0; m < 4; ++m) _Pragma("unroll") for (int n = 0; n < 2; ++n) { \
        if constexpr (FP8) asm volatile("s_nop 1\n\tv_mfma_scale_f32_16x16x128_f8f6f4 %0, %1, %2, %0, %3, %4 op_sel_hi:[0,0,0]" : "+v"(acc[ai][bj][m][n]) : "v"(Bt##8[n]), "v"(At##8[m]), "v"(wsc_), "v"(asc_));     \
        else { _Pragma("unroll") for (int k = 0; k < 2; ++k) acc[ai][bj][m][n] = __builtin_amdgcn_mfma_f32_16x16x32_bf16(Bt[n][k], At[m][k], acc[ai][bj][m][n], 0, 0, 0); } } \
        __builtin_amdgcn_s_setprio(0); } while (0)
#define PG8_WAIT_V(n) asm volatile("s_waitcnt vmcnt(" #n ")" ::: "memory")
#define PG8_WAIT_L(n) asm volatile("s_waitcnt lgkmcnt(" #n ")" ::: "memory")
#define PG8_BAR __builtin_amdgcn_s_barrier()
#define PG8_SCHED __builtin_amdgcn_sched_barrier(0)
    Unit cur, nxt; int ui = 0;
    if (!S.next(0, cur)) return;
    f32x4 acc[2][2][4][2];
#pragma unroll
    for (int a = 0; a < 2; ++a)
#pragma unroll
        for (int b = 0; b < 2; ++b)
#pragma unroll
            for (int m = 0; m < 4; ++m)
#pragma unroll
                for (int n = 0; n < 2; ++n) acc[a][b][m][n] = (f32x4){0.f, 0.f, 0.f, 0.f};
    int wsc_ = g.wscale, asc_ = 0x7f7f7f7f; asm volatile("" : "+v"(wsc_), "+v"(asc_));
    bf16x8 At[4][2], B0[2][2], B1[2][2]; v8i At8[4], B08[2], B18[2];
    if constexpr (GATHER) {
        PG8_LAS int* tab = (PG8_LAS int*)(lds + g.tab_off); Unit uu;
        for (int i = 0; S.next(i, uu); ++i) for (int r = tid; r < BM; r += 512) tab[i * BM + r] = g.arow[(size_t)uu.pm * BM + r];
        asm volatile("s_waitcnt vmcnt(0) lgkmcnt(0)" ::: "memory"); __builtin_amdgcn_s_barrier(); asm volatile("" ::: "memory");
#pragma unroll
        for (int hf = 0; hf < 2; ++hf)
#pragma unroll
            for (int i = 0; i < 2; ++i) vAc[hf][i] = ((unsigned)tab[hf * HALF + gR[i]] * (unsigned)K + (unsigned)gC[i]) * 2u;
    }
    const char* cA = (const char*)g.A + (GATHER ? (size_t)0 : (size_t)cur.pm * tstep); const char* cB = (const char*)g.Bt + (size_t)(cur.pm / g.tpg) * g.gstride + (size_t)cur.pn * tstep;
    S.a_ready(cur);
    if constexpr (SP2) {
        PG8_STAGE(PG8_SB(0, 0), cB, voffB); PG8_STAGE(PG8_SB(0, 1), cB + hstep, voffB); PG8_STAGE(PG8_SA(0, 0), cA, (GATHER ? vAc[0] : voffA)); PG8_STAGE(PG8_SA(0, 1), cA + hstepA, (GATHER ? vAc[1] : voffA));
        if (wr == 1) PG8_BAR;
        PG8_WAIT_V(2); PG8_BAR;
        PG8_STAGE(PG8_SB(1, 0), cB + kstep, voffB); PG8_STAGE(PG8_SA(1, 0), cA + kstep, (GATHER ? vAc[0] : voffA)); PG8_STAGE(PG8_SB(1, 1), cB + hstep + kstep, voffB);
        PG8_WAIT_V(6); PG8_BAR;
    } else {
        PG8_STAGE(PG8_SB(0, 0), cB, voffB); PG8_STAGE(PG8_SA(0, 0), cA, voffA); PG8_STAGE(PG8_SB(0, 1), cB + hstep, voffB); PG8_STAGE(PG8_SA(0, 1), cA + hstep, voffA);
        if (wr == 1) PG8_BAR;
        PG8_WAIT_V(4); PG8_BAR;
        PG8_STAGE(PG8_SB(1, 0), cB + kstep, voffB); PG8_STAGE(PG8_SA(1, 0), cA + kstep, voffA); PG8_STAGE(PG8_SB(1, 1), cB + hstep + kstep, voffB);
        PG8_WAIT_V(6); PG8_BAR;
    }
    for (;;) {
        const bool has_next = S.next(ui + 1, nxt);
        const char* nA = (has_next && !GATHER) ? (const char*)g.A + (size_t)nxt.pm * tstep : cA; const char* nB = has_next ? (const char*)g.Bt + (size_t)(nxt.pm / g.tpg) * g.gstride + (size_t)nxt.pn * tstep : cB;
        if constexpr (GATHER) { PG8_LAS int* tab = (PG8_LAS int*)(lds + g.tab_off);
#pragma unroll
            for (int hf = 0; hf < 2; ++hf)
#pragma unroll
                for (int i = 0; i < 2; ++i) vAn[hf][i] = has_next ? ((unsigned)tab[(ui + 1) * BM + hf * HALF + gR[i]] * (unsigned)K + (unsigned)gC[i]) * 2u : vAc[hf][i]; }
        for (int t = 0; t < nt; t += 2) {
            const bool last = (t == nt - 2);
            if constexpr (GATHER) {
#pragma unroll
                for (int hf = 0; hf < 2; ++hf)
#pragma unroll
                    for (int i = 0; i < 2; ++i) vS[hf][i] = last ? vAn[hf][i] : vAc[hf][i]; }
            const char* a1 = cA + (size_t)(t + 1) * kstep;
            const char* a2 = last ? nA : cA + (size_t)(t + 2) * kstep; const char* b2 = last ? nB : cB + (size_t)(t + 2) * kstep;
            const char* a3 = a2 + kstep; const char* b3 = b2 + kstep;
            if (last && has_next) S.a_ready(nxt);
            if constexpr (SP2) {
            PG8_LDB(B0, 0, 0); PG8_LDB(B1, 0, 1); PG8_SCHED; PG8_LDA(At, 0, 0); PG8_STAGE(PG8_SA(1, 1), a1 + hstepA, (GATHER ? vAc[1] : voffA));
            PG8_WAIT_V(8); PG8_WAIT_L(0); PG8_BAR; PG8_MMA(0, 0, At, B0); PG8_MMA(0, 1, At, B1); PG8_BAR; PG8_SCHED;
            PG8_LDA(At, 0, 1); PG8_STAGE(PG8_SB(0, 0), b2, voffB); PG8_STAGE(PG8_SB(0, 1), b2 + hstep, voffB); PG8_STAGE(PG8_SA(0, 0), a2, (GATHER ? vS[0] : voffA));
            PG8_WAIT_V(8); PG8_WAIT_L(0); PG8_BAR; PG8_MMA(1, 0, At, B0); PG8_MMA(1, 1, At, B1); PG8_BAR; PG8_SCHED;
            PG8_LDB(B0, 1, 0); PG8_LDB(B1, 1, 1); PG8_SCHED; PG8_LDA(At, 1, 0); PG8_STAGE(PG8_SA(0, 1), a2 + hstepA, (GATHER ? vS[1] : voffA));
            PG8_WAIT_V(8); PG8_WAIT_L(0); PG8_BAR; PG8_MMA(0, 0, At, B0); PG8_MMA(0, 1, At, B1); PG8_BAR; PG8_SCHED;
            PG8_LDA(At, 1, 1); PG8_STAGE(PG8_SB(1, 0), b3, voffB); PG8_STAGE(PG8_SB(1, 1), b3 + hstep, voffB); PG8_STAGE(PG8_SA(1, 0), a3, (GATHER ? vS[0] : voffA));
            PG8_WAIT_V(8); PG8_WAIT_L(0); PG8_BAR; PG8_MMA(1, 0, At, B0); PG8_MMA(1, 1, At, B1); PG8_BAR; PG8_SCHED;
            } else {
            PG8_LDB(B0, 0, 0); PG8_SCHED; PG8_LDA(At, 0, 0); PG8_STAGE(PG8_SA(1, 1), a1 + hstep, voffA);
            PG8_WAIT_L(8); PG8_BAR; PG8_WAIT_L(0); PG8_MMA(0, 0, At, B0); PG8_BAR; PG8_SCHED;
            PG8_LDB(B1, 0, 1); PG8_STAGE(PG8_SB(0, 0), b2, voffB);
            PG8_BAR; PG8_WAIT_L(0); PG8_MMA(0, 1, At, B1); PG8_BAR;
            PG8_LDA(At, 0, 1); PG8_STAGE(PG8_SA(0, 0), a2, voffA);
            PG8_BAR; PG8_WAIT_L(0); PG8_MMA(1, 0, At, B0); PG8_BAR; PG8_SCHED;
            PG8_STAGE(PG8_SB(0, 1), b2 + hstep, voffB);
            PG8_WAIT_V(6); PG8_BAR; PG8_MMA(1, 1, At, B1); PG8_BAR;
            PG8_LDB(B0, 1, 0); PG8_SCHED; PG8_LDA(At, 1, 0); PG8_STAGE(PG8_SA(0, 1), a2 + hstep, voffA);
            PG8_WAIT_L(8); PG8_BAR; PG8_WAIT_L(0); PG8_MMA(0, 0, At, B0); PG8_BAR; PG8_SCHED;
            PG8_LDB(B1, 1, 1); PG8_STAGE(PG8_SB(1, 0), b3, voffB);
            PG8_BAR; PG8_WAIT_L(0); PG8_MMA(0, 1, At, B1); PG8_BAR;
            PG8_LDA(At, 1, 1); PG8_STAGE(PG8_SA(1, 0), a3, voffA);
            PG8_BAR; PG8_WAIT_L(0); PG8_MMA(1, 0, At, B0); PG8_BAR; PG8_SCHED;
            PG8_STAGE(PG8_SB(1, 1), b3 + hstep, voffB);
            PG8_WAIT_V(6); PG8_BAR; PG8_MMA(1, 1, At, B1); PG8_BAR;
            }
        }
        if constexpr (ALIGN_EPI) { if (wr == 0) PG8_BAR; }
        if constexpr (FP8) {
            asm volatile("s_nop 15\n\ts_nop 15" : "+v"(acc[0][0][0][0]), "+v"(acc[0][0][0][1]), "+v"(acc[0][0][1][0]), "+v"(acc[0][0][1][1]), "+v"(acc[0][0][2][0]), "+v"(acc[0][0][2][1]), "+v"(acc[0][0][3][0]), "+v"(acc[0][0][3][1]),
                         "+v"(acc[0][1][0][0]), "+v"(acc[0][1][0][1]), "+v"(acc[0][1][1][0]), "+v"(acc[0][1][1][1]), "+v"(acc[0][1][2][0]), "+v"(acc[0][1][2][1]), "+v"(acc[0][1][3][0]), "+v"(acc[0][1][3][1]));
            asm volatile("" : "+v"(acc[1][0][0][0]), "+v"(acc[1][0][0][1]), "+v"(acc[1][0][1][0]), "+v"(acc[1][0][1][1]), "+v"(acc[1][0][2][0]), "+v"(acc[1][0][2][1]), "+v"(acc[1][0][3][0]), "+v"(acc[1][0][3][1]),
                         "+v"(acc[1][1][0][0]), "+v"(acc[1][1][0][1]), "+v"(acc[1][1][1][0]), "+v"(acc[1][1][1][1]), "+v"(acc[1][1][2][0]), "+v"(acc[1][1][2][1]), "+v"(acc[1][1][3][0]), "+v"(acc[1][1][3][1])); }
        if constexpr (!Epi::AFTER_DRAIN) { E(acc, cur, wr, wc, fr, fq); S.done(cur); }
        if (!has_next) break;
#pragma unroll
        for (int a = 0; a < 2; ++a)
#pragma unroll
            for (int b = 0; b < 2; ++b)
#pragma unroll
                for (int m = 0; m < 4; ++m)
#pragma unroll
                    for (int n = 0; n < 2; ++n) acc[a][b][m][n] = (f32x4){0.f, 0.f, 0.f, 0.f};
        cur = nxt; cA = nA; cB = nB; ++ui;
        if constexpr (GATHER) {
#pragma unroll
            for (int hf = 0; hf < 2; ++hf)
#pragma unroll
                for (int i = 0; i < 2; ++i) vAc[hf][i] = vAn[hf][i]; }
        if constexpr (ALIGN_EPI) { if (wr == 1) PG8_BAR; }
    }
    PG8_WAIT_V(0);
    if constexpr (!ALIGN_EPI) { if (wr == 0) PG8_BAR; }
    PG8_BAR;
    if constexpr (Epi::AFTER_DRAIN) { E.fused(acc, cur, wr, wc, fr, fq, lds, wid, lane); S.done(cur); }
#undef PG8_SA
#undef PG8_SB
#undef PG8_STAGE
#undef PG8_LD8
#undef PG8_LDA
#undef PG8_LDB
#undef PG8_MMA
#undef PG8_WAIT_V
#undef PG8_WAIT_L
#undef PG8_BAR
#undef PG8_SCHED
}
}
constexpr int NB = 16, SEQ = 2048, DM = 1024, MT = NB * SEQ;
constexpr int INC = 3488, INCP = 3584;
constexpr int NE = 16, CAP = 256, DFF = 2048, NGRP = 2, EPG = NE / NGRP, MG = EPG * NB * CAP;
constexpr int C_Q = 0, C_K = 512, C_V = 1024, C_RW = 1536, C_RR = 1536, C_RK = 2048, C_RV = 2560, C_WL = 3072, C_AL = 3200, C_GL = 3328;
constexpr float NORM_EPS = 1e-6f, RW_LN_EPS = 64e-5f, LOG2E = 1.4426950408889634f;
constexpr int NWAVES = 8, NTHR = 512;
enum { I_X = 0, I_P, I_RELB, I_GMIX, I_WIN, I_WOUT, I_QG, I_KG, I_LQ1, I_LK1, I_LQ2, I_LK2, I_SUBLN, I_MU, I_W0, I_W2L, I_A0, I_A2L, I_G2L, I_KK, I_KA, I_RK, I_LNG, I_LNB,
       I_GFFN, I_WR, I_W1, I_W3, I_W2, I_GPLE, I_WPG, I_WPLE, I_GPOST, N_IN };
constexpr size_t MiB = 1u << 20;
constexpr size_t WS_CTL = 0, CTL_ZERO_BYTES = 1 * MiB;
constexpr size_t WS_WIN = 1 * MiB, WS_WOUT = 8 * MiB, WS_WPG = 10 * MiB, WS_WPLE = 12 * MiB;
constexpr size_t WS_LW2 = 12 * MiB + 512 * 1024, WS_LA2 = WS_LW2 + 131072, WS_LG2 = WS_LA2 + 131072;
constexpr size_t WS_XN = 14 * MiB, WS_QN = 14 * MiB, WS_KN = 46 * MiB;
constexpr size_t WS_HB = 14 * MiB;
constexpr size_t WS_H2B = 334 * MiB;
constexpr size_t WS_HN8 = 430 * MiB;
constexpr size_t WS_U = 78 * MiB;
constexpr size_t WS_W13 = 462 * MiB, WS_W2T = 142 * MiB;
constexpr size_t WS_YE = 174 * MiB;
constexpr size_t WS_HDN = 302 * MiB;
constexpr size_t WS_HN2 = 302 * MiB;
constexpr size_t WS_VT = 302 * MiB, WS_MIX = 334 * MiB, WS_Y = 398 * MiB, WS_BON = 526 * MiB, WS_PB = 544 * MiB;
constexpr size_t WS_PE = 78 * MiB;
constexpr size_t WS_AFF = 526 * MiB, WS_SEL = 528 * MiB, WS_RMAP = 530 * MiB, WS_GATE = WS_RMAP + 262144, WS_PERS = WS_GATE + 262144;
constexpr int TAB_OFF = 132096;
constexpr size_t WS_END = 560 * MiB;
constexpr int CW_TMO = 0, CW_CODE = 1, CW_BAR = 4096;
constexpr int RING_OFF = 0, RING_BYTES = 131072, LDSCTL_OFF = RING_BYTES, MISC_OFF = LDSCTL_OFF + 320, LDS_BYTES = 148480;

#define GAS __attribute__((address_space(1)))
#define LAS __attribute__((address_space(3)))
typedef unsigned short bf16;
typedef unsigned v4u __attribute__((ext_vector_type(4)));
typedef unsigned v2u __attribute__((ext_vector_type(2)));
typedef float f32x4 __attribute__((ext_vector_type(4)));
typedef float f32x16 __attribute__((ext_vector_type(16)));
typedef short bf16x8 __attribute__((ext_vector_type(8)));
typedef GAS unsigned gu32;
#define RLX_AGENT __ATOMIC_RELAXED, __HIP_MEMORY_SCOPE_AGENT
#define LDS_WAIT() asm volatile("s_waitcnt lgkmcnt(0)" ::: "memory")
#define VM_WAIT() asm volatile("s_waitcnt vmcnt(0)" ::: "memory")
#define WG_BAR() do { asm volatile("s_waitcnt lgkmcnt(0)" ::: "memory"); __builtin_amdgcn_s_barrier(); asm volatile("" ::: "memory"); } while (0)
#define MFMA32(a, b, c) __builtin_amdgcn_mfma_f32_32x32x16_bf16((a), (b), (c), 0, 0, 0)
using pg8::cvt_pk_bf16; using pg8::fast_sigmoid;
__device__ __forceinline__ float bflo(unsigned w) { return __builtin_bit_cast(float, w << 16); }
__device__ __forceinline__ float bfhi(unsigned w) { return __builtin_bit_cast(float, w & 0xffff0000u); }
__device__ __forceinline__ void unpack8(const v4u w, float (&f)[8]) { f[0] = bflo(w.x); f[1] = bfhi(w.x); f[2] = bflo(w.y); f[3] = bfhi(w.y); f[4] = bflo(w.z); f[5] = bfhi(w.z); f[6] = bflo(w.w); f[7] = bfhi(w.w); }
__device__ __forceinline__ v4u pack8(const float (&f)[8]) { v4u w; w.x = cvt_pk_bf16(f[0], f[1]); w.y = cvt_pk_bf16(f[2], f[3]); w.z = cvt_pk_bf16(f[4], f[5]); w.w = cvt_pk_bf16(f[6], f[7]); return w; }
__device__ __forceinline__ float fexp2(float x) { return __builtin_amdgcn_exp2f(x); }
__device__ __forceinline__ float frcp(float x) { return __builtin_amdgcn_rcpf(x); }
__device__ __forceinline__ float wave_sum(float v) {
#pragma unroll
    for (int o = 1; o < 64; o <<= 1) v += __shfl_xor(v, o);
    return v;
}
template <int CTRL> __device__ __forceinline__ float dpp_f(float x) { return __builtin_bit_cast(float, __builtin_amdgcn_update_dpp(0, __builtin_bit_cast(int, x), CTRL, 0xF, 0xF, true)); }
__device__ __forceinline__ float sum8(float p) { p += dpp_f<0xB1>(p); p += dpp_f<0x4E>(p); p += dpp_f<0x141>(p); return p; }

#define XB_TMO      128
#define XB_XCNT(j)  (256  + 64 * (j))
#define XB_XSUB(j)  (1280 + 64 * (j))
#define XB_XGEN(j)  (2304 + 64 * (j))
#define XB_TOP      3328
#define XB_TOPGEN   3392
#define XCD_BAR_WORDS 3456
#define XB_SPIN_CAP (1u << 18)
__device__ __forceinline__ unsigned xb_ld(unsigned* p)              { return __hip_atomic_load(p, __ATOMIC_RELAXED, __HIP_MEMORY_SCOPE_AGENT); }
__device__ __forceinline__ unsigned xb_add(unsigned* p, unsigned v) { return __hip_atomic_fetch_add(p, v, __ATOMIC_RELAXED, __HIP_MEMORY_SCOPE_AGENT); }
__device__ __forceinline__ unsigned xb_xcc_id() { return (unsigned)__builtin_amdgcn_s_getreg((3 << 11) | 20) & 0xFu; }
#define XB_SPIN(cond, bar) do { unsigned _sp = 0; while (cond) { __builtin_amdgcn_s_sleep(1); \
    if ((++_sp & 255u) == 0u) { if (xb_ld(&(bar)[XB_TMO])) break; if (_sp > XB_SPIN_CAP) { atomicAdd(&(bar)[XB_TMO], 1u); break; } } } } while (0)
__device__ __forceinline__ int fresh_lane() { int l; asm volatile("v_mbcnt_lo_u32_b32 %0, -1, 0\n\tv_mbcnt_hi_u32_b32 %0, -1, %0" : "=v"(l)); return l; }
struct XcdBarrier { unsigned* bar; unsigned x; volatile LAS unsigned* st; int w; };
__device__ __forceinline__ XcdBarrier xcd_barrier_post(unsigned* bar, volatile LAS unsigned* st, int wave) {
    XcdBarrier b; b.bar = bar; b.x = xb_xcc_id(); b.st = st; b.w = wave;
    if (wave == 0 && fresh_lane() == 0) (void)xb_add(&bar[XB_XCNT(b.x)], 1u);
    return b;
}
__device__ __forceinline__ void xcd_barrier_complete(unsigned* bar, unsigned x, unsigned& nloc, unsigned& nx) {
    const unsigned G = gridDim.x * gridDim.y * gridDim.z;
    unsigned sum, cnt, mine, sp = 0u;
    for (;;) {
        sum = 0u; cnt = 0u; mine = 0u;
#pragma unroll
        for (unsigned j = 0; j < 16; ++j) { const unsigned c = xb_ld(&bar[XB_XCNT(j)]); sum += c; cnt += (c > 0u) ? 1u : 0u; mine = (j == x) ? c : mine; }
        if (sum == G) break;
        __builtin_amdgcn_s_sleep(1);
        if ((++sp & 255u) == 0u) { if (xb_ld(&bar[XB_TMO])) break; if (sp > XB_SPIN_CAP) { atomicAdd(&bar[XB_TMO], 1u); break; } }
    }
    nloc = mine > 0u ? mine : 1u; nx = cnt > 0u ? cnt : 1u;
}
__device__ __forceinline__ void xcd_barrier(const XcdBarrier& b) {
    asm volatile("s_waitcnt vmcnt(0)" ::: "memory");
    __syncthreads();
    if (b.w == 0 && fresh_lane() == 0) {
        unsigned* bar = b.bar;
        __builtin_amdgcn_s_waitcnt(0);
        unsigned nloc = b.st[0], nx = b.st[1];
        if (nloc == 0u) { xcd_barrier_complete(bar, b.x, nloc, nx); b.st[0] = nloc; b.st[1] = nx; }
        const unsigned old = xb_add(&bar[XB_XSUB(b.x)], 1u);
        const unsigned gen = old / nloc;
        if (old + 1u == (gen + 1u) * nloc) {
            __builtin_amdgcn_fence(__ATOMIC_RELEASE, "agent");
            asm volatile("s_waitcnt vmcnt(0)" ::: "memory");
            const unsigned og = xb_add(&bar[XB_TOP], 1u);
            const unsigned tg = og / nx;
            if (og + 1u == (tg + 1u) * nx) xb_add(&bar[XB_TOPGEN], 1u);
            else XB_SPIN(xb_ld(&bar[XB_TOPGEN]) == tg, bar);
            __builtin_amdgcn_fence(__ATOMIC_ACQUIRE, "agent");
            xb_add(&bar[XB_XGEN(b.x)], 1u);
            asm volatile("s_waitcnt vmcnt(0)" ::: "memory");
        } else {
            XB_SPIN(xb_ld(&bar[XB_XGEN(b.x)]) == gen, bar);
            __builtin_amdgcn_fence(__ATOMIC_ACQUIRE, "agent");
            asm volatile("s_waitcnt vmcnt(0)" ::: "memory");
        }
    }
    __syncthreads();
}

struct Args { const float* in[N_IN]; float* out; unsigned char* ws; int ph_lo, ph_hi, li, pad; };
struct Ctx { LAS unsigned char* lds; int tid, lane, wave, G, vcu; };

__device__ __forceinline__ void transpose_item(const float* W, int N, bf16* WT, int ldo, int dest_row0, int k0, int n0, LAS float* scr, int lane) {
#pragma unroll 8
    for (int i = 0; i < 32; ++i) { const int kk = 2 * i + (lane >> 5); scr[kk * 33 + (lane & 31)] = W[(size_t)(k0 + kk) * N + n0 + (lane & 31)]; }
    LDS_WAIT(); asm volatile("" ::: "memory");
    const int c = lane & 7;
#pragma unroll
    for (int j = 0; j < 4; ++j) { const int n = (lane >> 3) + 8 * j; const LAS float* s = scr + (8 * c) * 33 + n;
        v4u o; o.x = cvt_pk_bf16(s[0 * 33], s[1 * 33]); o.y = cvt_pk_bf16(s[2 * 33], s[3 * 33]); o.z = cvt_pk_bf16(s[4 * 33], s[5 * 33]); o.w = cvt_pk_bf16(s[6 * 33], s[7 * 33]);
        *(GAS v4u*)(WT + (size_t)(dest_row0 + n) * ldo + k0 + 8 * c) = o; }
    LDS_WAIT(); asm volatile("" ::: "memory");
}
__device__ __forceinline__ void transpose_item_fp8(const float* W, int N, unsigned char* WT, int ldo, int dest_row0, int k0, int n0, float scale, LAS float* scr, int lane) {
#pragma unroll 8
    for (int i = 0; i < 32; ++i) { const int kk = 2 * i + (lane >> 5); scr[kk * 33 + (lane & 31)] = W[(size_t)(k0 + kk) * N + n0 + (lane & 31)]; }
    LDS_WAIT(); asm volatile("" ::: "memory");
    const int c = lane & 3;
#pragma unroll
    for (int j = 0; j < 2; ++j) { const int n = (lane >> 2) + 16 * j; const LAS float* sp = scr + (16 * c) * 33 + n;
        v4u o; o.x = pg8::cvt4_fp8(sp[0 * 33] * scale, sp[1 * 33] * scale, sp[2 * 33] * scale, sp[3 * 33] * scale); o.y = pg8::cvt4_fp8(sp[4 * 33] * scale, sp[5 * 33] * scale, sp[6 * 33] * scale, sp[7 * 33] * scale);
        o.z = pg8::cvt4_fp8(sp[8 * 33] * scale, sp[9 * 33] * scale, sp[10 * 33] * scale, sp[11 * 33] * scale); o.w = pg8::cvt4_fp8(sp[12 * 33] * scale, sp[13 * 33] * scale, sp[14 * 33] * scale, sp[15 * 33] * scale);
        *(GAS v4u*)(WT + (size_t)(dest_row0 + n) * ldo + k0 + 16 * c) = o; }
    LDS_WAIT(); asm volatile("" ::: "memory");
}
constexpr float WSCALE = 32.0f; constexpr int WSCALE_E8M0 = 0x7a7a7a7a;
__device__ __forceinline__ void p0_prologue(const Args& a, const Ctx& F) {
    unsigned char* ws = a.ws;
    LAS float* scr = (LAS float*)(F.lds + RING_OFF + F.wave * 16384);
    const int gw = F.vcu * NWAVES + F.wave, NGW = F.G * NWAVES;
    constexpr int I0 = 16 * 109, I1 = I0 + 512, I2 = I1 + 512, I3 = I2 + 128, I4 = I3 + 32, I5 = I4 + 32;
    for (int it = gw; it < I5; it += NGW) {
        if (it < I0) { const int kb = it / 109, nb = it % 109; transpose_item(a.in[I_WIN], INC, (bf16*)(ws + WS_WIN), DM, 32 * nb, 64 * kb, 32 * nb, scr, F.lane); }
        else if (it < I1) { const int r = it - I0, kb = r >> 5, nb = r & 31; transpose_item(a.in[I_WOUT], DM, (bf16*)(ws + WS_WOUT), DM, 32 * nb, 64 * kb, 32 * nb, scr, F.lane); }
        else if (it < I2) { const int r = it - I1, kb = r >> 5, nb = r & 31; transpose_item_fp8(a.in[I_WPG], DM, ws + WS_WPG, DM, 32 * nb, 64 * kb, 32 * nb, WSCALE, scr, F.lane); }
        else if (it < I3) { const int r = it - I2, kb = r >> 5, nb = r & 31; transpose_item(a.in[I_WPLE], DM, (bf16*)(ws + WS_WPLE), 256, 32 * nb, 64 * kb, 32 * nb, scr, F.lane); }
        else if (it < I4) { const int r = it - I3, d = r >> 4, nb = r & 15; transpose_item(a.in[I_W2L] + (size_t)d * 64 * 512, 512, (bf16*)(ws + WS_LW2) + (size_t)d * 512 * 64, 64, 32 * nb, 0, 32 * nb, scr, F.lane); }
        else { const int r = it - I4, d = r >> 4, nb = r & 15; transpose_item(a.in[I_A2L] + (size_t)d * 64 * 512, 512, (bf16*)(ws + WS_LA2) + (size_t)d * 512 * 64, 64, 32 * nb, 0, 32 * nb, scr, F.lane); }
    }
    const int gt = F.vcu * NTHR + F.tid, NGT = F.G * NTHR;
    for (int i = gt; i < (INCP - INC) * DM / 8; i += NGT) *(GAS v4u*)((bf16*)(ws + WS_WIN) + (size_t)INC * DM + (size_t)i * 8) = (v4u){0u, 0u, 0u, 0u};
    for (int i = gt; i < 512 * 192; i += NGT) { const int n = i / 192, k = i % 192; const float v = k < 160 ? a.in[I_G2L][(size_t)k * 512 + n] : 0.f; ((bf16*)(ws + WS_LG2))[i] = (bf16)(cvt_pk_bf16(v, 0.f) & 0xffffu); }
    for (int i = gt; i < MT * 256 / 8; i += NGT) { const f32x4 x0 = *(const GAS f32x4*)(a.in[I_P] + (size_t)i * 8), x1 = *(const GAS f32x4*)(a.in[I_P] + (size_t)i * 8 + 4);
        v4u o; o.x = cvt_pk_bf16(x0[0], x0[1]); o.y = cvt_pk_bf16(x0[2], x0[3]); o.z = cvt_pk_bf16(x1[0], x1[1]); o.w = cvt_pk_bf16(x1[2], x1[3]); *(GAS v4u*)((bf16*)(ws + WS_PB) + (size_t)i * 8) = o; }
    const float* gm = a.in[I_GMIX];
    for (int m = gw; m < MT; m += 4 * NGW) {
        f32x4 v[4][4];
#pragma unroll
        for (int r = 0; r < 4; ++r) { const int mr = min(m + r * NGW, MT - 1); const GAS f32x4* xr = (const GAS f32x4*)(a.in[I_X] + (size_t)mr * DM) + F.lane;
#pragma unroll
            for (int j = 0; j < 4; ++j) v[r][j] = xr[64 * j]; }
#pragma unroll
        for (int r = 0; r < 4; ++r) { const int mr = m + r * NGW; float s = 0.f;
#pragma unroll
            for (int j = 0; j < 4; ++j) s += (v[r][j][0] * v[r][j][0] + v[r][j][1] * v[r][j][1]) + (v[r][j][2] * v[r][j][2] + v[r][j][3] * v[r][j][3]);
            const float rstd = 1.0f / sqrtf(wave_sum(s) * (1.f / DM) + NORM_EPS);
            if (mr < MT) { GAS v2u* o8 = (GAS v2u*)((bf16*)(ws + WS_XN) + (size_t)mr * DM) + F.lane;
#pragma unroll
                for (int j = 0; j < 4; ++j) { const f32x4 g = *(const f32x4*)(gm + 4 * F.lane + 256 * j); v2u o; o.x = cvt_pk_bf16(v[r][j][0] * rstd * g[0], v[r][j][1] * rstd * g[1]); o.y = cvt_pk_bf16(v[r][j][2] * rstd * g[2], v[r][j][3] * rstd * g[3]); o8[64 * j] = o; } } }
    }
}
struct ConvItem { const float* src; unsigned char* dst; };
template <int KIND> __device__ __forceinline__ ConvItem conv_item(const Args& a, int it) {
    ConvItem c;
    if constexpr (KIND == 0) { const int e = it >> 11, r = it & 2047, w3 = r >> 10, q = r & 1023, kb = q >> 6, nb = q & 63, n0 = 32 * nb;
        c.src = a.in[w3 ? I_W3 : I_W1] + (size_t)e * DM * DFF + (size_t)(64 * kb) * DFF + n0;
        c.dst = a.ws + WS_W13 + (size_t)e * 4096 * DM + (size_t)(256 * (n0 >> 7) + (n0 & 127) + 128 * w3) * DM + 64 * kb; }
    else { const int e = it >> 10, q = it & 1023, kb = q >> 5, nb = q & 31;
        c.src = a.in[I_W2] + (size_t)e * DFF * DM + (size_t)(64 * kb) * DM + 32 * nb;
        c.dst = a.ws + WS_W2T + (size_t)e * DM * DFF + (size_t)(32 * nb) * DFF + 64 * kb; }
    return c;
}
template <int KIND> __device__ __forceinline__ void conv_stream(const Args& a, const Ctx& F, int j0, int j1) {
    constexpr int TOTAL = KIND == 0 ? NE * 2048 : NE * 1024, PS = KIND == 0 ? DFF : DM, PD = KIND == 0 ? DM : DFF;
    LAS float* scr = (LAS float*)(F.lds + RING_OFF + F.wave * 16384);
    const int gw = F.vcu * NWAVES + F.wave, NGW = F.G * NWAVES, lane = F.lane;
    { const int jmax = (TOTAL - gw + NGW - 1) / NGW; if (j1 > jmax) j1 = jmax; }
    if (j0 >= j1) return;
    const int lo = (lane >> 5) * PS + (lane & 31);
    float va[32], vb[32]; unsigned char* da; unsigned char* db = nullptr;
    { const ConvItem c = conv_item<KIND>(a, gw + j0 * NGW); da = c.dst;
#pragma unroll
      for (int i = 0; i < 32; ++i) va[i] = c.src[(size_t)(2 * i) * PS + lo]; }
    if (j0 + 1 < j1) { const ConvItem c = conv_item<KIND>(a, gw + (j0 + 1) * NGW); db = c.dst;
#pragma unroll
      for (int i = 0; i < 32; ++i) vb[i] = c.src[(size_t)(2 * i) * PS + lo]; }
#define CONV_STEP(v_, d_, j_) { unsigned char* dst = d_; \
        _Pragma("unroll") for (int i = 0; i < 32; ++i) scr[(2 * i + (lane >> 5)) * 33 + (lane & 31)] = v_[i]; \
        if ((j_) + 2 < j1) { const ConvItem c = conv_item<KIND>(a, gw + ((j_) + 2) * NGW); d_ = c.dst; \
            _Pragma("unroll") for (int i = 0; i < 32; ++i) v_[i] = c.src[(size_t)(2 * i) * PS + lo]; } \
        LDS_WAIT(); asm volatile("" ::: "memory"); \
        const int cq = lane & 3; \
        _Pragma("unroll") for (int jj = 0; jj < 2; ++jj) { const int n = (lane >> 2) + 16 * jj; const LAS float* sp = scr + (16 * cq) * 33 + n; \
            v4u o; o.x = pg8::cvt4_fp8(sp[0 * 33] * WSCALE, sp[1 * 33] * WSCALE, sp[2 * 33] * WSCALE, sp[3 * 33] * WSCALE); o.y = pg8::cvt4_fp8(sp[4 * 33] * WSCALE, sp[5 * 33] * WSCALE, sp[6 * 33] * WSCALE, sp[7 * 33] * WSCALE); \
            o.z = pg8::cvt4_fp8(sp[8 * 33] * WSCALE, sp[9 * 33] * WSCALE, sp[10 * 33] * WSCALE, sp[11 * 33] * WSCALE); o.w = pg8::cvt4_fp8(sp[12 * 33] * WSCALE, sp[13 * 33] * WSCALE, sp[14 * 33] * WSCALE, sp[15 * 33] * WSCALE); \
            *(GAS v4u*)(dst + (size_t)n * PD + 16 * cq) = o; } \
        LDS_WAIT(); asm volatile("" ::: "memory"); }
    for (int j = j0; j < j1; j += 2) {
        CONV_STEP(va, da, j)
        if (j + 1 < j1) CONV_STEP(vb, db, j + 1)
    }
#undef CONV_STEP
}
__device__ __forceinline__ void p2_attn_prep(const Args& a, const Ctx& F) {
    unsigned char* ws = a.ws; const bf16* U = (const bf16*)(ws + WS_U);
    bf16* QN = (bf16*)(ws + WS_QN); bf16* KN = (bf16*)(ws + WS_KN); bf16* VT = (bf16*)(ws + WS_VT);
    const int lane = F.lane, sv = lane >> 2, d0 = (lane & 3) * 16;
    float gq[16];
    { const float* g = (sv < 8) ? a.in[I_QG] : a.in[I_KG]; const float sc = (sv < 8) ? 0.125f * LOG2E : 1.0f;
#pragma unroll
      for (int i = 0; i < 16; ++i) gq[i] = g[d0 + i] * sc; }
    for (int u = F.vcu; u < MT / 64; u += F.G) {
        const int m0 = u * 64, b = m0 / SEQ, s0 = m0 % SEQ;
#pragma unroll 2
        for (int i = 0; i < 8; ++i) { const int tk = F.wave * 8 + i; const bf16* row = U + (size_t)(m0 + tk) * INCP + lane * 16;
            const v4u w0 = *(const GAS v4u*)row, w1 = *(const GAS v4u*)(row + 8);
            float x[16]; { float t0[8], t1[8]; unpack8(w0, t0); unpack8(w1, t1);
#pragma unroll
              for (int j = 0; j < 8; ++j) { x[j] = t0[j]; x[8 + j] = t1[j]; } }
            float ss = 0.f;
#pragma unroll
            for (int j = 0; j < 16; ++j) ss += x[j] * x[j];
            ss += dpp_f<0xB1>(ss); ss += dpp_f<0x4E>(ss);
            const float rn = 1.0f / sqrtf(ss * (1.f / 64.f) + NORM_EPS);
            float y0[8], y1[8];
#pragma unroll
            for (int j = 0; j < 8; ++j) { y0[j] = x[j] * rn * gq[j]; y1[j] = x[8 + j] * rn * gq[8 + j]; }
            const int svl = sv & 7, hh = svl >> 1, c = svl & 1;
            bf16* dst = ((sv < 8) ? QN : KN) + ((size_t)((b * 4 + hh) * 2 + c) * SEQ + s0 + tk) * 64 + d0;
            *(GAS v4u*)dst = pack8(y0); *(GAS v4u*)(dst + 8) = pack8(y1); }
        LAS unsigned char* T = F.lds + RING_OFF;
#pragma unroll
        for (int i = 0; i < 8; ++i) { const int p = F.tid + 512 * i, tk = p >> 6, ch = p & 63;
            const v4u w = *(const GAS v4u*)(U + (size_t)(m0 + tk) * INCP + C_V + ch * 8); *(LAS v4u*)(T + tk * 1040 + ch * 16) = w; }
        LDS_WAIT(); __syncthreads();
        { const int dv = F.tid;
          bf16* dst = VT + ((size_t)(b * 4 + (dv >> 7)) * 128 + (dv & 127)) * SEQ + s0;
#pragma unroll
          for (int g = 0; g < 8; ++g) { unsigned short e[8];
#pragma unroll
              for (int j = 0; j < 8; ++j) e[j] = *(const LAS unsigned short*)(T + (8 * g + j) * 1040 + dv * 2);
              v4u o; o.x = e[0] | ((unsigned)e[1] << 16); o.y = e[2] | ((unsigned)e[3] << 16); o.z = e[4] | ((unsigned)e[5] << 16); o.w = e[6] | ((unsigned)e[7] << 16);
              *(GAS v4u*)(dst + 8 * g) = o; } }
        LDS_WAIT(); __syncthreads();
    }
}

__device__ __forceinline__ void mix8(const bf16* Ub, int t, int col, const float* mu, float (&x)[8]) {
    const v4u z = {0u, 0u, 0u, 0u};
    const v4u w0 = *(const GAS v4u*)(Ub + (size_t)t * INCP + col);
    const v4u wm = (t > 0) ? *(const GAS v4u*)(Ub + (size_t)(t - 1) * INCP + col) : z;
    const v4u wp = (t < SEQ - 1) ? *(const GAS v4u*)(Ub + (size_t)(t + 1) * INCP + col) : z;
    const f32x4 m0 = *(const f32x4*)(mu + col - C_RW), m1 = *(const f32x4*)(mu + col - C_RW + 4);
    float u0[8], um[8], up[8]; unpack8(w0, u0); unpack8(wm, um); unpack8(wp, up);
#pragma unroll
    for (int j = 0; j < 8; ++j) { const float mj = j < 4 ? m0[j] : m1[j - 4]; x[j] = u0[j] + mj * (0.5f * (um[j] + up[j]) - u0[j]); }
}
__device__ __forceinline__ int t5_bucket(int rel) {
    const int n = rel < 0 ? -rel : rel; const int ret = rel > 0 ? 16 : 0;
    int lg = 8 + (n >= 12) + (n >= 16) + (n >= 23) + (n >= 32) + (n >= 46) + (n >= 64) + (n >= 91); lg = lg < 15 ? lg : 15;
    return ret + (n < 8 ? n : lg);
}
__device__ __forceinline__ int swz(int row, int chunk) { return row * 128 + ((chunk ^ ((row >> 1) & 7)) << 4); }
__device__ __forceinline__ void p3_attn_unit(const Args& a, const Ctx& F, int unit, float lam) {
    unsigned char* ws = a.ws;
    const int b = unit >> 6, h = (unit >> 4) & 3, qt = unit & 15, q0 = qt * 128;
    int tid_ = F.tid, wave_ = F.wave; asm volatile("" : "+v"(tid_), "+s"(wave_));
    const int tid = tid_, lane = tid & 63, wave = wave_, c = wave >> 2, qw = wave & 3, l31 = lane & 31, hh = lane >> 5;
    const bf16* KNb = (const bf16*)(ws + WS_KN) + (size_t)((b * 4 + h) * 2) * SEQ * 64;
    const bf16* VTb = (const bf16*)(ws + WS_VT) + (size_t)(b * 4 + h) * 128 * SEQ;
    LAS unsigned char* KV = F.lds + RING_OFF;
    LAS float* BT = (LAS float*)(F.lds + RING_OFF + 65536);
    const float* relb = a.in[I_RELB];
    for (int i = tid; i < 641; i += NTHR) BT[i] = relb[t5_bucket(i - 320) * 4 + h] * LOG2E;
    const float cL = relb[15 * 4 + h] * LOG2E, cR = relb[31 * 4 + h] * LOG2E;
    bf16x8 qf[4];
    { const bf16* Qp = (const bf16*)(ws + WS_QN) + ((size_t)((b * 4 + h) * 2 + c) * SEQ + q0 + 32 * qw + l31) * 64 + 8 * hh;
#pragma unroll
      for (int ks = 0; ks < 4; ++ks) qf[ks] = *(const GAS bf16x8*)(Qp + 16 * ks); }
    const bf16* gsrc[4]; int ldst[4];
#pragma unroll
    for (int i = 0; i < 4; ++i) { const int p = tid + 512 * i;
        if (p < 1024) { const int cc = p >> 9, row = (p & 511) >> 3, ch = p & 7; gsrc[i] = KNb + ((size_t)cc * SEQ + row) * 64 + ch * 8; ldst[i] = cc * 8192 + swz(row, ch); }
        else { const int q = p - 1024, row = q >> 3, ch = q & 7; gsrc[i] = VTb + (size_t)row * SEQ + ch * 8; ldst[i] = 16384 + swz(row, ch); } }
    const int pr = (l31 & 19) | ((l31 & 4) << 1) | ((l31 & 8) >> 1);
    f32x16 O[4];
#pragma unroll
    for (int d = 0; d < 4; ++d)
#pragma unroll
        for (int i = 0; i < 16; ++i) O[d][i] = 0.f;
    float bnd;
    { float gq_ = fabsf(a.in[I_QG][lane]), gk_ = fabsf(a.in[I_KG][lane]), bm_ = lane < 32 ? fabsf(relb[lane * 4 + h]) : 0.f;
#pragma unroll
      for (int o = 32; o > 0; o >>= 1) { gq_ = fmaxf(gq_, __shfl_xor(gq_, o)); gk_ = fmaxf(gk_, __shfl_xor(gk_, o)); bm_ = fmaxf(bm_, __shfl_xor(bm_, o)); }
      bnd = 8.0f * LOG2E * gq_ * gk_ + LOG2E * bm_; }
    const bool need_max = !(bnd < 40.0f);
    float mrun = need_max ? -1e30f : 0.f, lrun = 0.f;
    const int qpos = q0 + 32 * qw + l31;
    v4u stg[4];
#pragma unroll
    for (int i = 0; i < 4; ++i) stg[i] = *(const GAS v4u*)(gsrc[i] + (i < 2 ? 0 : 0));
#pragma unroll
    for (int i = 0; i < 4; ++i) *(LAS v4u*)(KV + ldst[i]) = stg[i];
    LDS_WAIT(); __syncthreads();
    for (int t = 0; t < SEQ / 64; ++t) {
        const int k0 = t * 64; LAS unsigned char* buf = KV + (t & 1) * 32768;
        if (t + 1 < SEQ / 64) {
#pragma unroll
            for (int i = 0; i < 4; ++i) stg[i] = *(const GAS v4u*)(gsrc[i] + (i < 2 ? (size_t)(k0 + 64) * 64 : (size_t)(k0 + 64)));
        }
        f32x16 st[2];
#pragma unroll
        for (int kt = 0; kt < 2; ++kt)
#pragma unroll
            for (int i = 0; i < 16; ++i) st[kt][i] = 0.f;
#pragma unroll
        for (int ks = 0; ks < 4; ++ks)
#pragma unroll
            for (int kt = 0; kt < 2; ++kt) { const bf16x8 kf = *(const LAS bf16x8*)(buf + c * 8192 + swz(32 * kt + pr, 2 * ks + hh)); st[kt] = MFMA32(kf, qf[ks], st[kt]); }
        const int relmax = k0 + 63 - q0, relmin = k0 - q0 - 127;
        float cb = 0.f;
        if (relmax <= -91) cb = cL; else if (relmin >= 91) cb = cR;
        else { int boff_ = (k0 - qpos + 320 + 8 * hh) * 4 + 65536; asm volatile("" : "+v"(boff_)); const LAS float* btp_ = (const LAS float*)(F.lds + RING_OFF + boff_);
#pragma unroll
            for (int kt = 0; kt < 2; ++kt)
#pragma unroll
                for (int r = 0; r < 16; ++r) st[kt][r] += btp_[32 * kt + 16 * (r >> 3) + (r & 7)];
        }
        if (need_max) {
        float mx = st[0][0];
#pragma unroll
        for (int kt = 0; kt < 2; ++kt)
#pragma unroll
            for (int r = 0; r < 16; ++r) mx = fmaxf(mx, st[kt][r]);
        mx += cb;
        mx = fmaxf(mx, __shfl_xor(mx, 32));
        if (__any(mx - mrun > 8.0f)) {
            const float mnew = fmaxf(mrun, mx), alpha = fexp2(mrun - mnew); mrun = mnew; lrun *= alpha;
#pragma unroll
            for (int d = 0; d < 4; ++d)
#pragma unroll
                for (int i = 0; i < 16; ++i) O[d][i] *= alpha; }
        }
        const float sub = cb - mrun;
        float ps = 0.f;
#pragma unroll
        for (int kt = 0; kt < 2; ++kt)
#pragma unroll
            for (int r = 0; r < 16; ++r) { st[kt][r] = fexp2(st[kt][r] + sub); ps += st[kt][r]; }
        lrun += ps;
        bf16x8 pf[2][2];
#pragma unroll
        for (int kt = 0; kt < 2; ++kt)
#pragma unroll
            for (int s2 = 0; s2 < 2; ++s2) { v4u w; w.x = cvt_pk_bf16(st[kt][8 * s2 + 0], st[kt][8 * s2 + 1]); w.y = cvt_pk_bf16(st[kt][8 * s2 + 2], st[kt][8 * s2 + 3]); w.z = cvt_pk_bf16(st[kt][8 * s2 + 4], st[kt][8 * s2 + 5]); w.w = cvt_pk_bf16(st[kt][8 * s2 + 6], st[kt][8 * s2 + 7]);
                pf[kt][s2] = __builtin_bit_cast(bf16x8, w); }
#pragma unroll
        for (int kt = 0; kt < 2; ++kt)
#pragma unroll
            for (int s2 = 0; s2 < 2; ++s2)
#pragma unroll
                for (int d = 0; d < 4; ++d) { const bf16x8 vf = *(const LAS bf16x8*)(buf + 16384 + swz(32 * d + l31, 4 * kt + 2 * s2 + hh)); O[d] = MFMA32(vf, pf[kt][s2], O[d]); }
        if (t + 1 < SEQ / 64) { LAS unsigned char* nb = KV + ((t + 1) & 1) * 32768;
#pragma unroll
            for (int i = 0; i < 4; ++i) *(LAS v4u*)(nb + ldst[i]) = stg[i]; }
        LDS_WAIT(); __syncthreads();
    }
    const float ltot = lrun + __shfl_xor(lrun, 32), linv = 1.0f / ltot;
    LAS float* X = (LAS float*)(F.lds + RING_OFF);
    if (c == 1) {
        const float sc = lam * linv;
#pragma unroll
        for (int d = 0; d < 4; ++d)
#pragma unroll
            for (int r = 0; r < 16; ++r) X[((qw * 4 + d) * 16 + r) * 64 + lane] = O[d][r] * sc;
    }
    LDS_WAIT(); __syncthreads();
    if (c == 0) {
        float ssq = 0.f;
#pragma unroll
        for (int d = 0; d < 4; ++d)
#pragma unroll
            for (int r = 0; r < 16; ++r) { const float o = O[d][r] * linv - X[((qw * 4 + d) * 16 + r) * 64 + lane]; O[d][r] = o; ssq += o * o; }
        ssq += __shfl_xor(ssq, 32);
        const float rn = (1.0f / sqrtf(ssq * (1.f / 128.f) + NORM_EPS)) * 0.8f;
        const float* sg = a.in[I_SUBLN];
        bf16* orow = (bf16*)(ws + WS_MIX) + (size_t)(b * SEQ + qpos) * DM + h * 128;
#pragma unroll
        for (int d = 0; d < 4; ++d)
#pragma unroll
            for (int g = 0; g < 4; ++g) { const int dv = 32 * d + 8 * g + 4 * hh; const f32x4 gg = *(const f32x4*)(sg + dv);
                v2u w; w.x = cvt_pk_bf16(O[d][4 * g] * rn * gg[0], O[d][4 * g + 1] * rn * gg[1]); w.y = cvt_pk_bf16(O[d][4 * g + 2] * rn * gg[2], O[d][4 * g + 3] * rn * gg[3]);
                *(GAS v2u*)(orow + dv) = w; }
    }
    LDS_WAIT(); __syncthreads();
}
#ifndef NEU_STAGES
#define NEU_STAGES 2
#endif
namespace rw {
constexpr int SLOT = 8192;
constexpr int IM_QH = 0, IM_RH = 1, IM_KT = 2, IM_BT = 3, IM_KTT = 4, IM_BTT = 5, IM_VT = 6, IM_S0 = 7, IM_RHS = 7, IM_ABQ = 8, IM_ABQT = 9, IM_AKQ = 10, IM_UT = 10, IM_AKR = 11, IM_ABR = 12,
              IM_TA = 13, IM_TB = 14, IM_PA = 0, IM_PB = 2, IM_TW = 12, IM_AL = 6;
constexpr int OFF_YC = 13 * SLOT, OFF_LW = 8 * SLOT, OFF_LA = 10 * SLOT, OFF_MISC = 15 * SLOT;
enum Mask { M_NONE = 0, M_LT = 1, M_LE = 2, M_GT = 3 };
__device__ __forceinline__ f32x16 zero16() { f32x16 z;
#pragma unroll
    for (int i = 0; i < 16; ++i) z[i] = 0.f; return z; }
__device__ __forceinline__ f32x16 mm_tile(const LAS unsigned char* X, int xr0, const LAS unsigned char* Y, int yr0, f32x16 acc, int l31, int hh) {
    bf16x8 af[4], bf_[4];
#pragma unroll
    for (int s = 0; s < 4; ++s) { af[s] = *(const LAS bf16x8*)(X + swz(xr0 + l31, 2 * s + hh)); bf_[s] = *(const LAS bf16x8*)(Y + swz(yr0 + l31, 2 * s + hh)); }
    asm volatile("s_waitcnt lgkmcnt(0)" : "+v"(af[0]), "+v"(af[1]), "+v"(af[2]), "+v"(af[3]), "+v"(bf_[0]), "+v"(bf_[1]), "+v"(bf_[2]), "+v"(bf_[3]));
#pragma unroll
    for (int s = 0; s < 4; ++s) acc = MFMA32(af[s], bf_[s], acc);
    return acc;
}
template <int MODE> __device__ __forceinline__ void store_T(LAS unsigned char* img, const f32x16& d, int r0, int c0, int l31, int hh) {
    const int c = c0 + l31;
#pragma unroll
    for (int g = 0; g < 4; ++g) { float v[4];
#pragma unroll
        for (int j = 0; j < 4; ++j) { const int r = r0 + 8 * g + 4 * hh + j; const bool keep = MODE == M_NONE ? true : MODE == M_LT ? (r < c) : MODE == M_LE ? (r <= c) : (c < r); v[j] = keep ? d[4 * g + j] : 0.f; }
        v2u w; w.x = cvt_pk_bf16(v[0], v[1]); w.y = cvt_pk_bf16(v[2], v[3]);
        *(LAS v2u*)(img + swz(c, (r0 >> 3) + g) + 8 * hh) = w; }
}
__device__ __forceinline__ f32x16 load_T(const LAS unsigned char* img, int r0, int c0, int l31, int hh) {
    f32x16 d; const int c = c0 + l31;
#pragma unroll
    for (int g = 0; g < 4; ++g) { const v2u w = *(const LAS v2u*)(img + swz(c, (r0 >> 3) + g) + 8 * hh); d[4 * g] = bflo(w.x); d[4 * g + 1] = bfhi(w.x); d[4 * g + 2] = bflo(w.y); d[4 * g + 3] = bfhi(w.y); }
    return d;
}
__device__ __forceinline__ void put16(LAS unsigned char* img, int row, int col, float v) { *(LAS unsigned short*)(img + swz(row, col >> 3) + (col & 7) * 2) = (unsigned short)(cvt_pk_bf16(v, 0.f) & 0xffffu); }
}

__device__ __forceinline__ unsigned bperm_u(int addr4, unsigned v) { return (unsigned)__builtin_amdgcn_ds_bpermute(addr4, (int)v); }
__device__ __forceinline__ float bperm_f(int addr4, float v) { return __builtin_bit_cast(float, __builtin_amdgcn_ds_bpermute(addr4, __builtin_bit_cast(int, v))); }
struct MixRaw { v4u w0, we; };
__device__ __forceinline__ void mix_load(const bf16* gbase, unsigned toff, unsigned eoff, bool edge, MixRaw& r) {
    const v4u z = {0u, 0u, 0u, 0u};
    r.w0 = *(const GAS v4u*)((const GAS char*)gbase + toff);
    r.we = edge ? *(const GAS v4u*)((const GAS char*)gbase + eoff) : z;
}
#define MIX_OFFS(t_, toff_, eoff_, edge_) const unsigned toff_ = ((unsigned)(t_) * INCP + fc) * 2u; \
    const int te_##toff_ = (lane < 8) ? (dir ? (t_) + 1 : (t_) - 1) : (dir ? (t_) - 1 : (t_) + 1);     \
    const bool edge_ = (lane < 8 || lane >= 56) && te_##toff_ >= 0 && te_##toff_ < SEQ; const unsigned eoff_ = ((unsigned)te_##toff_ * INCP + fc) * 2u
__device__ __forceinline__ void mix_compute(const MixRaw& r, int lane, const LAS float* mul, float (&x)[8]) {
    const f32x4 m0 = *(const LAS f32x4*)mul, m1 = *(const LAS f32x4*)(mul + 4);
    v4u wa, wb;
    const int up4 = ((lane - 8) & 63) << 2, dn4 = ((lane + 8) & 63) << 2;
    wa.x = bperm_u(up4, r.w0.x); wa.y = bperm_u(up4, r.w0.y); wa.z = bperm_u(up4, r.w0.z); wa.w = bperm_u(up4, r.w0.w);
    wb.x = bperm_u(dn4, r.w0.x); wb.y = bperm_u(dn4, r.w0.y); wb.z = bperm_u(dn4, r.w0.z); wb.w = bperm_u(dn4, r.w0.w);
    if (lane < 8) wa = r.we;
    if (lane >= 56) wb = r.we;
    float u0[8], um[8], up[8]; unpack8(r.w0, u0); unpack8(wa, um); unpack8(wb, up);
#pragma unroll
    for (int j = 0; j < 8; ++j) { const float mj = j < 4 ? m0[j] : m1[j - 4]; x[j] = u0[j] + mj * (0.5f * (um[j] + up[j]) - u0[j]); }
}
__device__ __forceinline__ void p3_scan_unit_chunked(const Args& a, const Ctx& F, int unit) {
    using namespace rw;
    unsigned char* ws = a.ws;
    int wave_ = F.wave; asm volatile("" : "+s"(wave_)); const int tid_ = wave_ * 64 + fresh_lane();
    const int dir = unit >> 7, b = (unit >> 3) & 15, h = unit & 7, tid = tid_, lane = tid & 63, wave = wave_, l31 = lane & 31, hh = lane >> 5;
    const bf16* Ub = (const bf16*)(ws + WS_U) + (size_t)b * SEQ * INCP;
    bf16* Y = (bf16*)(ws + WS_Y) + ((size_t)dir * MT + (size_t)b * SEQ) * 512 + h * 64;
    float* BON = (float*)(ws + WS_BON) + ((size_t)dir * MT + (size_t)b * SEQ) * 8 + h;
    LAS unsigned char* L = F.lds + RING_OFF;
#define IMG(s) (L + (s) * SLOT)
    LAS float* YC = (LAS float*)(L + OFF_YC); LAS float* LW = (LAS float*)(L + OFF_LW); LAS float* LA = (LAS float*)(L + OFF_LA);
    LAS float* WLAST = (LAS float*)(L + OFF_MISC); LAS float* WTOT = (LAS float*)(L + OFF_MISC + 256);
    const float* mu = a.in[I_MU];
    const int mat = wave >> 2, ti = (wave >> 1) & 1, ci = wave & 1;
    const bf16* LWp = (const bf16*)(ws + (mat ? WS_LA2 : WS_LW2)) + ((size_t)dir * 512 + h * 64 + 32 * ci + l31) * 64 + 8 * hh;
    const float c0 = (mat ? a.in[I_A0] : a.in[I_W0])[dir * 512 + h * 64 + 32 * ci + l31];
    const int fi = tid >> 3, c8 = tid & 7, fc = c8 * 8;
    const int w4 = wave & 3, tb = w4 >> 1, vb = w4 & 1;
    f32x16 acc_s = zero16();
    for (int i = tid; i < SLOT / 16; i += NTHR) *(LAS v4u*)(IMG(IM_S0) + i * 16) = (v4u){0u, 0u, 0u, 0u};
    LAS float* MUL = (LAS float*)(L + OFF_MISC + 2560);
    const int gcol0 = C_RR + h * 64, gcol1 = C_RK + h * 64, gcol2 = C_RV + h * 64, gcol3 = C_WL + dir * 64, gcol4 = C_AL + dir * 64;
    if (tid < 320) { const int g = tid >> 6, cc = tid & 63; MUL[tid] = mu[(g == 0 ? gcol0 : g == 1 ? gcol1 : g == 2 ? gcol2 : g == 3 ? gcol3 : gcol4) - C_RW + cc]; }
    else if (tid < 512) { const int g = (tid - 320) >> 6, cc = tid & 63; MUL[tid] = (g == 0 ? a.in[I_KK] : g == 1 ? a.in[I_KA] : a.in[I_RK])[h * 64 + cc]; }
    LAS unsigned char* LORAB = F.lds + TAB_OFF + (mat * 2 + ci) * 4096 + lane * 16;
    if (ti == 0) {
#pragma unroll
        for (int ks = 0; ks < 4; ++ks) *(LAS bf16x8*)(LORAB + ks * 1024) = *(const GAS bf16x8*)(LWp + 16 * ks); }
    MixRaw R0, R1, R2;
    MixRaw R3, R4;
    const bf16* G0 = Ub + gcol0; const bf16* G1 = Ub + gcol1; const bf16* G2 = Ub + gcol2; const bf16* G3 = Ub + gcol3; const bf16* G4 = Ub + gcol4;
    { const int t0 = dir ? (SEQ - 1 - fi) : fi; MIX_OFFS(t0, to, eo, ed); mix_load(G0, to, eo, ed, R0); mix_load(G1, to, eo, ed, R1); mix_load(G2, to, eo, ed, R2); mix_load(G3, to, eo, ed, R3); mix_load(G4, to, eo, ed, R4); }
    WG_BAR();
    for (int chn = 0; chn < SEQ / 64; ++chn) {
        const int sidx = chn * 64 + fi, t = dir ? (SEQ - 1 - sidx) : sidx;
        float r8[8], k8[8], v8[8];
        mix_compute(R0, lane, MUL + fc, r8); mix_compute(R1, lane, MUL + 64 + fc, k8); mix_compute(R2, lane, MUL + 128 + fc, v8);
        { float x[8]; mix_compute(R3, lane, MUL + 192 + fc, x);
#pragma unroll
          for (int j = 0; j < 8; ++j) x[j] = 1.0f - 2.0f * frcp(1.0f + fexp2(2.0f * LOG2E * x[j]));
          *(LAS v4u*)(IMG(IM_TW) + swz(fi, c8)) = pack8(x);
          mix_compute(R4, lane, MUL + 256 + fc, x); *(LAS v4u*)(IMG(IM_AL) + swz(fi, c8)) = pack8(x); }
        if (chn + 1 < SEQ / 64) { const int s1 = (chn + 1) * 64 + fi, t1 = dir ? (SEQ - 1 - s1) : s1;
            MIX_OFFS(t1, to, eo, ed); mix_load(G0, to, eo, ed, R0); mix_load(G1, to, eo, ed, R1); mix_load(G2, to, eo, ed, R2); }
        WG_BAR();
        { f32x16 acc = zero16();
#pragma unroll
          for (int ks = 0; ks < 4; ++ks) { const bf16x8 af = *(const LAS bf16x8*)(IMG(mat ? IM_AL : IM_TW) + swz(32 * ti + l31, 2 * ks + hh)); const bf16x8 bq = *(const LAS bf16x8*)(LORAB + ks * 1024); acc = MFMA32(af, bq, acc); }
          LAS float* dst = mat ? LA : LW;
#pragma unroll
          for (int r = 0; r < 16; ++r) dst[(32 * ti + (r & 3) + 8 * (r >> 2) + 4 * hh) * 64 + 32 * ci + l31] = acc[r] + c0; }
        WG_BAR();
        float lw2[8], av[8], kkv[8], kd[8], bb[8];
        { const f32x4 w0 = *(LAS f32x4*)(LW + fi * 64 + fc), w1 = *(LAS f32x4*)(LW + fi * 64 + fc + 4), a0 = *(LAS f32x4*)(LA + fi * 64 + fc), a1 = *(LAS f32x4*)(LA + fi * 64 + fc + 4);
          float ssq = 0.f, bon = 0.f;
#pragma unroll
          for (int j = 0; j < 8; ++j) { const float wl = j < 4 ? w0[j] : w1[j - 4], al = j < 4 ? a0[j] : a1[j - 4];
              lw2[j] = -0.60653065971f * LOG2E * fast_sigmoid(wl); av[j] = fast_sigmoid(al);
              kkv[j] = k8[j] * MUL[320 + fc + j]; ssq += kkv[j] * kkv[j]; kd[j] = k8[j] * (1.0f + (av[j] - 1.0f) * MUL[384 + fc + j]); bon += r8[j] * kd[j] * MUL[448 + fc + j]; }
          ssq = sum8(ssq); bon = sum8(bon);
          const float inv = 1.0f / fmaxf(sqrtf(ssq), 1e-12f);
#pragma unroll
          for (int j = 0; j < 8; ++j) { kkv[j] *= inv; bb[j] = kkv[j] * av[j]; }
          if (c8 == 0) BON[(size_t)t * 8] = bon; }
        float cum[8];
#pragma unroll
        for (int j = 0; j < 8; ++j) { float x = lw2[j]; float y = bperm_f(((lane - 8) & 63) << 2, x); if (lane >= 8) x += y; y = bperm_f(((lane - 16) & 63) << 2, x); if (lane >= 16) x += y; y = bperm_f(((lane - 32) & 63) << 2, x); if (lane >= 32) x += y; cum[j] = x; }
        if (lane >= 56) {
#pragma unroll
            for (int j = 0; j < 8; ++j) WTOT[wave * 64 + fc + j] = cum[j]; }
        WG_BAR();
#pragma unroll 1
        for (int w = 0; w < wave; ++w) { const f32x4 t0 = *(LAS f32x4*)(WTOT + w * 64 + fc), t1 = *(LAS f32x4*)(WTOT + w * 64 + fc + 4);
#pragma unroll
            for (int j = 0; j < 4; ++j) { cum[j] += t0[j]; cum[4 + j] += t1[j]; } }
        { float qh[8], rh[8], kt[8], bt[8];
#pragma unroll
          for (int j = 0; j < 8; ++j) { const float W = fexp2(cum[j]), Wm = fexp2(cum[j] - lw2[j]), Wi = fexp2(-cum[j]);
              qh[j] = kkv[j] * Wm; rh[j] = r8[j] * W; kt[j] = kd[j] * Wi; bt[j] = bb[j] * Wi;
              if (fi == 63) WLAST[fc + j] = W; }
          *(LAS v4u*)(IMG(IM_QH) + swz(fi, c8)) = pack8(qh); *(LAS v4u*)(IMG(IM_RH) + swz(fi, c8)) = pack8(rh);
          *(LAS v4u*)(IMG(IM_KT) + swz(fi, c8)) = pack8(kt); *(LAS v4u*)(IMG(IM_BT) + swz(fi, c8)) = pack8(bt);
#pragma unroll
          for (int j = 0; j < 8; ++j) { put16(IMG(IM_KTT), fc + j, fi, kt[j]); put16(IMG(IM_BTT), fc + j, fi, bt[j]); put16(IMG(IM_VT), fc + j, fi, v8[j]); } }
        WG_BAR();
        f32x16 acc_t;
        acc_t = mm_tile(IMG(wave < 4 ? IM_QH : IM_RH), 32 * tb, IMG(IM_S0), 32 * vb, zero16(), l31, hh);
#pragma unroll 1
        for (int tt = wave; tt < 20; tt += 8) { const int p = tt >> 2, rb = (tt >> 1) & 1, cb = tt & 1;
            if (p == 4 ? (rb < cb) : (rb > cb)) {
                const int im = p == 0 ? IM_AKQ : p == 1 ? IM_ABQ : p == 2 ? IM_AKR : p == 3 ? IM_ABR : IM_ABQT;
#pragma unroll
                for (int g = 0; g < 4; ++g) *(LAS v2u*)(IMG(im) + swz(32 * cb + l31, 4 * rb + g) + 8 * hh) = (v2u){0u, 0u};
                if (p == 1) {
#pragma unroll
                    for (int g = 0; g < 4; ++g) *(LAS v2u*)(IMG(IM_TA) + swz(32 * cb + l31, 4 * rb + g) + 8 * hh) = (v2u){0u, 0u}; }
                continue; }
            const int xs = (p == 0 || p == 2) ? IM_KT : (p == 4 ? IM_QH : IM_BT), ys = (p == 0 || p == 1) ? IM_QH : (p == 4 ? IM_BT : IM_RH);
            const f32x16 d = mm_tile(IMG(xs), 32 * rb, IMG(ys), 32 * cb, zero16(), l31, hh);
            if (p == 0) store_T<M_LT>(IMG(IM_AKQ), d, 32 * rb, 32 * cb, l31, hh);
            else if (p == 1) { store_T<M_LT>(IMG(IM_ABQ), d, 32 * rb, 32 * cb, l31, hh);
                f32x16 t1;
#pragma unroll
                for (int q = 0; q < 16; ++q) { const int r = 32 * rb + (q & 3) + 8 * (q >> 2) + 4 * hh, c = 32 * cb + l31; t1[q] = (r == c ? 1.0f : 0.f) - (r < c ? d[q] : 0.f); }
                store_T<M_NONE>(IMG(IM_TA), t1, 32 * rb, 32 * cb, l31, hh); }
            else if (p == 2) store_T<M_LE>(IMG(IM_AKR), d, 32 * rb, 32 * cb, l31, hh);
            else if (p == 3) store_T<M_LE>(IMG(IM_ABR), d, 32 * rb, 32 * cb, l31, hh);
            else store_T<M_GT>(IMG(IM_ABQT), d, 32 * rb, 32 * cb, l31, hh); }
        WG_BAR();
        if (wave < 4) { acc_t = mm_tile(IMG(IM_AKQ), 32 * tb, IMG(IM_VT), 32 * vb, acc_t, l31, hh); store_T<M_NONE>(IMG(IM_RHS), acc_t, 32 * tb, 32 * vb, l31, hh); }
        else {
#pragma unroll 1
            for (int q = 0; q < 2; ++q) { const int tt = 2 * w4 + q, tr = (tt >> 1) & 1, rb = (tt >> 2), cb = tt & 1;
                const f32x16 d = mm_tile(IMG(tr ? IM_ABQ : IM_ABQT), 32 * rb, IMG(tr ? IM_ABQT : IM_ABQ), 32 * cb, zero16(), l31, hh);
                store_T<M_NONE>(IMG(IM_PA + tr), d, 32 * rb, 32 * cb, l31, hh); } }
        WG_BAR();
        if (wave < 4) { f32x16 d = load_T(IMG(IM_TA), 32 * tb, 32 * vb, l31, hh);
            d = mm_tile(IMG(IM_PA + 1), 32 * tb, IMG(IM_TA), 32 * vb, d, l31, hh);
            store_T<M_NONE>(IMG(IM_TB), d, 32 * tb, 32 * vb, l31, hh); }
        else { f32x16 d = mm_tile(IMG(IM_PA + 1), 32 * tb, IMG(IM_PA), 32 * vb, zero16(), l31, hh);
            store_T<M_NONE>(IMG(IM_PB), d, 32 * tb, 32 * vb, l31, hh);
            d = mm_tile(IMG(IM_TA), 32 * tb, IMG(IM_RHS), 32 * vb, zero16(), l31, hh);
            store_T<M_NONE>(IMG(IM_ABQ), d, 32 * tb, 32 * vb, l31, hh); }
        WG_BAR();
        if (chn + 1 < SEQ / 64) { const int s1 = (chn + 1) * 64 + fi, t1 = dir ? (SEQ - 1 - s1) : s1; MIX_OFFS(t1, to, eo, ed); mix_load(G3, to, eo, ed, R3); mix_load(G4, to, eo, ed, R4); }
        if (wave < 4) { f32x16 d = mm_tile(IMG(IM_TB), 32 * tb, IMG(IM_RHS), 32 * vb, zero16(), l31, hh); d = mm_tile(IMG(IM_PB), 32 * tb, IMG(IM_ABQ), 32 * vb, d, l31, hh); store_T<M_NONE>(IMG(IM_UT), d, 32 * tb, 32 * vb, l31, hh); }
        WG_BAR();
        if (wave >= 4) { acc_t = mm_tile(IMG(IM_AKR), 32 * tb, IMG(IM_VT), 32 * vb, acc_t, l31, hh);
            const f32x16 m = mm_tile(IMG(IM_ABR), 32 * tb, IMG(IM_UT), 32 * vb, zero16(), l31, hh);
#pragma unroll
            for (int q = 0; q < 16; ++q) YC[(32 * tb + (q & 3) + 8 * (q >> 2) + 4 * hh) * 64 + 32 * vb + l31] = acc_t[q] - m[q]; }
        else { acc_s = mm_tile(IMG(IM_KTT), 32 * tb, IMG(IM_VT), 32 * vb, acc_s, l31, hh);
            const f32x16 m = mm_tile(IMG(IM_BTT), 32 * tb, IMG(IM_UT), 32 * vb, zero16(), l31, hh);
#pragma unroll
            for (int q = 0; q < 16; ++q) acc_s[q] = (acc_s[q] - m[q]) * WLAST[32 * tb + (q & 3) + 8 * (q >> 2) + 4 * hh]; }
        WG_BAR();
        if (wave < 4) store_T<M_NONE>(IMG(IM_S0), acc_s, 32 * tb, 32 * vb, l31, hh);
        { const f32x4 y0 = *(LAS f32x4*)(YC + fi * 64 + fc), y1 = *(LAS f32x4*)(YC + fi * 64 + fc + 4);
          v4u w; w.x = cvt_pk_bf16(y0[0], y0[1]); w.y = cvt_pk_bf16(y0[2], y0[3]); w.z = cvt_pk_bf16(y1[0], y1[1]); w.w = cvt_pk_bf16(y1[2], y1[3]);
          *(GAS v4u*)(Y + (size_t)t * 512 + fc) = w; }
    }
    WG_BAR();
#undef IMG
}
__device__ __forceinline__ void p4_unit(const Args& a, const Ctx& F, int unit) {
    unsigned char* ws = a.ws; const int tid = F.tid, lane = F.lane, wave = F.wave, l31 = lane & 31, hh = lane >> 5;
    const int m0 = unit * 32, b = m0 / SEQ, s0 = m0 % SEQ;
    const bf16* Ub = (const bf16*)(ws + WS_U) + (size_t)b * SEQ * INCP;
    LAS bf16* AS = (LAS bf16*)(F.lds + RING_OFF);
    LAS float* GS = (LAS float*)(F.lds + RING_OFF + 16384);
    const float* mu = a.in[I_MU];
    for (int it = tid; it < 640; it += NTHR) { const int tok = it / 20, g = it % 20; float x[8]; mix8(Ub, s0 + tok, C_GL + 8 * g, mu, x);
#pragma unroll
        for (int j = 0; j < 8; ++j) x[j] = fast_sigmoid(x[j]);
        *(LAS v4u*)(AS + tok * 168 + 8 * g) = pack8(x); }
    LDS_WAIT(); __syncthreads();
    const bf16* G2 = (const bf16*)(ws + WS_LG2);
#pragma unroll
    for (int cc = 0; cc < 2; ++cc) { const int ct = 2 * wave + cc; f32x16 acc;
#pragma unroll
        for (int i = 0; i < 16; ++i) acc[i] = 0.f;
#pragma unroll
        for (int ks = 0; ks < 10; ++ks) { const bf16x8 af = *(const LAS bf16x8*)(AS + l31 * 168 + 16 * ks + 8 * hh); const bf16x8 bf_ = *(const GAS bf16x8*)(G2 + (size_t)(32 * ct + l31) * 192 + 16 * ks + 8 * hh); acc = MFMA32(af, bf_, acc); }
#pragma unroll
        for (int r = 0; r < 16; ++r) GS[((r & 3) + 8 * (r >> 2) + 4 * hh) * 516 + 32 * ct + l31] = acc[r]; }
    LDS_WAIT(); __syncthreads();
    { const int tok = tid >> 4, sub = tid & 15, head = sub >> 1, ch0 = head * 64 + (sub & 1) * 32, m = m0 + tok, s = s0 + tok;
      const bf16* Yf = (const bf16*)(ws + WS_Y) + (size_t)m * 512 + ch0; const bf16* Yb = Yf + (size_t)MT * 512;
      float y[32]; float sm = 0.f;
#pragma unroll
      for (int q = 0; q < 4; ++q) { float f[8], g[8]; unpack8(*(const GAS v4u*)(Yf + 8 * q), f); unpack8(*(const GAS v4u*)(Yb + 8 * q), g);
#pragma unroll
          for (int j = 0; j < 8; ++j) { y[8 * q + j] = f[j] + g[j]; sm += y[8 * q + j]; } }
      sm += dpp_f<0xB1>(sm); const float mean = sm * (1.f / 64.f); float vs = 0.f;
#pragma unroll
      for (int j = 0; j < 32; ++j) { y[j] -= mean; vs += y[j] * y[j]; }
      vs += dpp_f<0xB1>(vs); const float rstd = 1.0f / sqrtf(vs * (1.f / 64.f) + RW_LN_EPS);
      const float* BF = (const float*)(ws + WS_BON) + (size_t)m * 8 + head; const float bonus = BF[0] + BF[(size_t)MT * 8];
      const float* lg = a.in[I_LNG] + ch0; const float* lb = a.in[I_LNB] + ch0;
      bf16* dst = (bf16*)(ws + WS_MIX) + (size_t)m * DM + 512 + ch0;
#pragma unroll
      for (int q = 0; q < 4; ++q) { float v[8]; mix8(Ub, s, C_RV + ch0 + 8 * q, mu, v); float o[8];
#pragma unroll
          for (int j = 0; j < 8; ++j) { const int cix = 8 * q + j; o[j] = (y[cix] * rstd * lg[cix] + lb[cix] + bonus * v[j]) * GS[tok * 516 + ch0 + cix]; }
          *(GAS v4u*)(dst + 8 * q) = pack8(o); } }
    LDS_WAIT(); __syncthreads();
}

__device__ __forceinline__ void p6_router(const Args& a, const Ctx& F) {
    unsigned char* ws = a.ws; const int lane = F.lane;
    const int gw = F.vcu * NWAVES + F.wave, NGW = F.G * NWAVES;
    const float* gf = a.in[I_GFFN]; const float* wr = a.in[I_WR];
    LAS float* WT = (LAS float*)(F.lds + RING_OFF);
    for (int i = F.tid; i < DM * 16; i += NTHR) WT[(i & 15) * DM + (i >> 4)] = wr[i];
    LDS_WAIT(); __syncthreads();
    const int nit = (MT + 2 * NGW - 1) / (2 * NGW);
    v2u xw[2][4];
#define ROUTER_LOAD(it_) { _Pragma("unroll") for (int r = 0; r < 2; ++r) { const int m_ = min(gw + (2 * (it_) + r) * NGW, MT - 1); \
        const GAS v2u* xr = (const GAS v2u*)((const bf16*)(ws + WS_HB) + (size_t)m_ * DM) + lane; \
        _Pragma("unroll") for (int j = 0; j < 4; ++j) xw[r][j] = xr[64 * j]; } }
    ROUTER_LOAD(0)
    for (int it = 0; it < nit; ++it) {
        f32x4 v[2][4]; float s[2] = {0.f, 0.f};
#pragma unroll
        for (int r = 0; r < 2; ++r) {
#pragma unroll
            for (int j = 0; j < 4; ++j) { const v2u w = xw[r][j]; v[r][j][0] = bflo(w.x); v[r][j][1] = bfhi(w.x); v[r][j][2] = bflo(w.y); v[r][j][3] = bfhi(w.y);
                s[r] += (v[r][j][0] * v[r][j][0] + v[r][j][1] * v[r][j][1]) + (v[r][j][2] * v[r][j][2] + v[r][j][3] * v[r][j][3]); }
        }
        if (it + 1 < nit) ROUTER_LOAD(it + 1)
        float lg[2][16];
#pragma unroll
        for (int r = 0; r < 2; ++r) { const int m = gw + (2 * it + r) * NGW; const bool ok = m < MT;
            const float rstd = 1.0f / sqrtf(wave_sum(s[r]) * (1.f / DM) + NORM_EPS);
            GAS unsigned* o8 = (GAS unsigned*)(ws + WS_HN8 + (size_t)(ok ? m : 0) * DM) + lane;
#pragma unroll
            for (int j = 0; j < 4; ++j) { const f32x4 g = *(const f32x4*)(gf + 4 * lane + 256 * j); v[r][j] = v[r][j] * rstd * g; if (ok) o8[64 * j] = pg8::cvt4_fp8(v[r][j][0], v[r][j][1], v[r][j][2], v[r][j][3]); }
        }
        int woff = 4 * lane; asm volatile("" : "+v"(woff));
#pragma unroll
        for (int e = 0; e < 16; ++e) { float a0 = 0.f, a1 = 0.f;
#pragma unroll
            for (int j = 0; j < 4; ++j) { const f32x4 w = *(const LAS f32x4*)(WT + e * DM + woff + 256 * j);
                a0 += (v[0][j][0] * w[0] + v[0][j][1] * w[1]) + (v[0][j][2] * w[2] + v[0][j][3] * w[3]); a1 += (v[1][j][0] * w[0] + v[1][j][1] * w[1]) + (v[1][j][2] * w[2] + v[1][j][3] * w[3]); }
            asm volatile("" : "+v"(a0), "+v"(a1));
            lg[0][e] = a0; lg[1][e] = a1; }
#pragma unroll
        for (int r = 0; r < 2; ++r) { const int m = gw + (2 * it + r) * NGW;
            float v8[8], v4[4], v2[2], v1;
            { const bool b5 = lane & 32, b4 = lane & 16, b3 = lane & 8, b2 = lane & 4;
#pragma unroll
              for (int j = 0; j < 8; ++j) { const float snd = b5 ? lg[r][j] : lg[r][8 + j], kp = b5 ? lg[r][8 + j] : lg[r][j]; v8[j] = kp + __shfl_xor(snd, 32); }
#pragma unroll
              for (int j = 0; j < 4; ++j) { const float snd = b4 ? v8[j] : v8[4 + j], kp = b4 ? v8[4 + j] : v8[j]; v4[j] = kp + __shfl_xor(snd, 16); }
#pragma unroll
              for (int j = 0; j < 2; ++j) { const float snd = b3 ? v4[j] : v4[2 + j], kp = b3 ? v4[2 + j] : v4[j]; v2[j] = kp + __shfl_xor(snd, 8); }
              { const float snd = b2 ? v2[0] : v2[1], kp = b2 ? v2[1] : v2[0]; v1 = kp + __shfl_xor(snd, 4); }
              v1 += __shfl_xor(v1, 2); v1 += __shfl_xor(v1, 1); }
            float mx = v1;
            mx = fmaxf(mx, __shfl_xor(mx, 32)); mx = fmaxf(mx, __shfl_xor(mx, 16)); mx = fmaxf(mx, __shfl_xor(mx, 8)); mx = fmaxf(mx, __shfl_xor(mx, 4));
            const float ex = fexp2((v1 - mx) * LOG2E);
            float den = ex; den += __shfl_xor(den, 32); den += __shfl_xor(den, 16); den += __shfl_xor(den, 8); den += __shfl_xor(den, 4);
            if (m < MT && (lane & 3) == 0) ((float*)(ws + WS_AFF))[((size_t)(m / SEQ) * 16 + (lane >> 2)) * SEQ + (m % SEQ)] = ex / den; }
    }
#undef ROUTER_LOAD
    { const int grp = lane >> 4, gl = lane & 15;
      for (int m0 = 4 * gw; m0 < MT; m0 += 4 * NGW) { const int m = m0 + grp;
          const GAS v4u* pr = (const GAS v4u*)((const bf16*)(ws + WS_PE) + (size_t)m * DM) + gl; v4u pw[8]; float ps = 0.f;
#pragma unroll
          for (int i = 0; i < 8; ++i) pw[i] = pr[16 * i];
#pragma unroll
          for (int i = 0; i < 8; ++i) { float t[8]; unpack8(pw[i], t);
#pragma unroll
              for (int j = 0; j < 8; ++j) ps += t[j] * t[j]; }
          ps = sum8(ps); ps += dpp_f<0x140>(ps);
          if (gl == 0) ((float*)(ws + WS_PERS))[m] = 1.0f / sqrtf(ps * (1.f / DM) + NORM_EPS); } }
    LDS_WAIT(); __syncthreads();
}

__device__ __forceinline__ void p7_topk_unit(const Args& a, const Ctx& F, int unit) {
    unsigned char* ws = a.ws; const int tid = F.tid, lane = F.lane, wave = F.wave;
    const int b = unit >> 4, e = unit & 15;
    LAS unsigned* hist = (LAS unsigned*)(F.lds + RING_OFF);
    LAS unsigned* ctl = hist + 256;
    LAS unsigned* wtot = hist + 320;
    const float* aff = (const float*)(ws + WS_AFF) + ((size_t)b * 16 + e) * SEQ;
    const f32x4 av = *(const GAS f32x4*)(aff + 4 * tid);
    unsigned key[4];
#pragma unroll
    for (int j = 0; j < 4; ++j) key[j] = __float_as_uint(av[j]);
    unsigned prefix = 0u, mask = 0u, krem = CAP;
#pragma unroll 1
    for (int pass = 3; pass >= 0; --pass) { const int sh = 8 * pass;
        if (tid < 256) hist[tid] = 0u;
        LDS_WAIT(); __syncthreads();
#pragma unroll
        for (int j = 0; j < 4; ++j) if ((key[j] & mask) == prefix) atomicAdd((unsigned*)&hist[(key[j] >> sh) & 255u], 1u);
        LDS_WAIT(); __syncthreads();
        if (wave == 0) {
            const unsigned h0 = hist[4 * lane], h1 = hist[4 * lane + 1], h2 = hist[4 * lane + 2], h3 = hist[4 * lane + 3];
            const unsigned tot = h0 + h1 + h2 + h3; unsigned suf = tot;
#pragma unroll
            for (int o = 1; o < 64; o <<= 1) { const unsigned t = __shfl_down(suf, o); if (lane + o < 64) suf += t; }
            const unsigned above = suf - tot;
            const unsigned g3 = above, g2 = above + h3, g1 = g2 + h2, g0 = g1 + h1;
            if (g3 < krem && krem <= g3 + h3) { ctl[0] = 4 * lane + 3; ctl[1] = krem - g3; }
            else if (g2 < krem && krem <= g2 + h2) { ctl[0] = 4 * lane + 2; ctl[1] = krem - g2; }
            else if (g1 < krem && krem <= g1 + h1) { ctl[0] = 4 * lane + 1; ctl[1] = krem - g1; }
            else if (g0 < krem && krem <= g0 + h0) { ctl[0] = 4 * lane + 0; ctl[1] = krem - g0; }
        }
        LDS_WAIT(); __syncthreads();
        prefix |= ctl[0] << sh; mask |= 255u << sh; krem = ctl[1];
        LDS_WAIT(); __syncthreads();
    }
    unsigned ngt = 0, neq = 0;
#pragma unroll
    for (int j = 0; j < 4; ++j) { ngt += key[j] > prefix; neq += key[j] == prefix; }
    unsigned pk = ngt | (neq << 16), inc = pk;
#pragma unroll
    for (int o = 1; o < 64; o <<= 1) { const unsigned t = __shfl_up(inc, o); if (lane >= o) inc += t; }
    if (lane == 63) wtot[wave] = inc;
    LDS_WAIT(); __syncthreads();
    unsigned base = 0, total = 0;
#pragma unroll
    for (int w = 0; w < 8; ++w) { const unsigned t = wtot[w]; if (w < wave) base += t; total += t; }
    unsigned ex = base + inc - pk; unsigned gpre = ex & 0xffffu, epre = ex >> 16; const unsigned cgt = total & 0xffffu;
    int* SEL = (int*)(ws + WS_SEL) + ((size_t)b * SEQ + 4 * tid) * 16 + e;
    int* RM = (int*)(ws + WS_RMAP) + ((size_t)e * NB + b) * CAP;
    float* GT = (float*)(ws + WS_GATE) + ((size_t)e * NB + b) * CAP;
#pragma unroll
    for (int j = 0; j < 4; ++j) { int slot = -1;
        if (key[j] > prefix) { slot = (int)gpre; ++gpre; }
        else if (key[j] == prefix) { if (epre < krem) slot = (int)(cgt + epre); ++epre; }
        SEL[j * 16] = slot;
        if (slot >= 0) { RM[slot] = b * SEQ + 4 * tid + j; GT[slot] = av[j]; } }
    LDS_WAIT(); __syncthreads();
}
__device__ __forceinline__ void moe_combine(const Args& a, const Ctx& F) {
    unsigned char* ws = a.ws; const int lane = F.lane, grp = lane >> 4, gl = lane & 15;
    const int gw = F.vcu * NWAVES + F.wave, NGW = F.G * NWAVES;
    const int* SEL = (const int*)(ws + WS_SEL); const float* gp = a.in[I_GPLE];
    const bf16* YE = (const bf16*)(ws + WS_YE);
    for (int m0 = 4 * gw; m0 < MT; m0 += 4 * NGW) {
        const int m = m0 + grp, b = m / SEQ;
        const int sl = SEL[(size_t)m * 16 + gl];
        const GAS v4u* hr = (const GAS v4u*)((const bf16*)(ws + WS_HB) + (size_t)m * DM) + gl;
        v4u hw[8];
#pragma unroll
        for (int i = 0; i < 8; ++i) hw[i] = hr[16 * i];
        const unsigned long long bal = __ballot(sl >= 0);
        unsigned mask = (unsigned)(bal >> (16 * grp)) & 0xffffu;
        const int cnt = __popc(mask);
        const int maxc = max(max(__builtin_amdgcn_readlane(cnt, 0), __builtin_amdgcn_readlane(cnt, 16)), max(__builtin_amdgcn_readlane(cnt, 32), __builtin_amdgcn_readlane(cnt, 48)));
        float acc[8][8];
#pragma unroll
        for (int i = 0; i < 8; ++i) unpack8(hw[i], acc[i]);
        for (int k = 0; k < maxc; k += 2) {
            const bool has1 = mask != 0u; const int e1 = (__ffs(mask) - 1) & 15; mask &= mask - 1u;
            const bool has2 = mask != 0u; const int e2 = (__ffs(mask) - 1) & 15; mask &= mask - 1u;
            const int s1 = __builtin_amdgcn_ds_bpermute(((grp << 4) + e1) << 2, sl), s2 = __builtin_amdgcn_ds_bpermute(((grp << 4) + e2) << 2, sl);
            const v4u z = {0u, 0u, 0u, 0u}; v4u r1[8], r2[8];
            const GAS v4u* y1 = (const GAS v4u*)(YE + (size_t)((e1 * NB + b) * CAP + (has1 ? s1 : 0)) * DM) + gl;
            const GAS v4u* y2 = (const GAS v4u*)(YE + (size_t)((e2 * NB + b) * CAP + (has2 ? s2 : 0)) * DM) + gl;
#pragma unroll
            for (int i = 0; i < 8; ++i) r1[i] = has1 ? y1[16 * i] : z;
#pragma unroll
            for (int i = 0; i < 8; ++i) r2[i] = has2 ? y2[16 * i] : z;
#pragma unroll
            for (int i = 0; i < 8; ++i) { float t[8]; unpack8(r1[i], t);
#pragma unroll
                for (int j = 0; j < 8; ++j) acc[i][j] += t[j]; }
#pragma unroll
            for (int i = 0; i < 8; ++i) { float t[8]; unpack8(r2[i], t);
#pragma unroll
                for (int j = 0; j < 8; ++j) acc[i][j] += t[j]; }
        }
        GAS v4u* h2r = (GAS v4u*)((bf16*)(ws + WS_H2B) + (size_t)m * DM) + gl;
        float s = 0.f;
#pragma unroll
        for (int i = 0; i < 8; ++i) { h2r[16 * i] = pack8(acc[i]);
#pragma unroll
            for (int j = 0; j < 8; ++j) s += acc[i][j] * acc[i][j]; }
        s = sum8(s); s += dpp_f<0x140>(s);
        const float rstd = 1.0f / sqrtf(s * (1.f / DM) + NORM_EPS);
        GAS v2u* o8 = (GAS v2u*)(ws + WS_HN2 + (size_t)m * DM) + gl;
#pragma unroll
        for (int i = 0; i < 8; ++i) { const f32x4 g0 = *(const f32x4*)(gp + 8 * (gl + 16 * i)), g1 = *(const f32x4*)(gp + 8 * (gl + 16 * i) + 4);
            v2u w; w.x = pg8::cvt4_fp8(acc[i][0] * rstd * g0[0], acc[i][1] * rstd * g0[1], acc[i][2] * rstd * g0[2], acc[i][3] * rstd * g0[3]);
            w.y = pg8::cvt4_fp8(acc[i][4] * rstd * g1[0], acc[i][5] * rstd * g1[1], acc[i][6] * rstd * g1[2], acc[i][7] * rstd * g1[3]); o8[16 * i] = w; }
    }
}
constexpr int NPHASE = 10;
__global__ void __launch_bounds__(NTHR, 2) fwd_kernel(Args args) {
    extern __shared__ __attribute__((aligned(16))) unsigned char lds[];
    Ctx F; F.lds = (LAS unsigned char*)lds; F.tid = threadIdx.x; F.lane = F.tid & 63; F.wave = __builtin_amdgcn_readfirstlane(F.tid >> 6);
    F.G = gridDim.x; { const int bx = blockIdx.x; F.vcu = (F.G % 8 == 0) ? (bx % 8) * (F.G / 8) + bx / 8 : bx; }
    unsigned char* ws = args.ws;
    for (int u = F.tid; u < (LDS_BYTES - LDSCTL_OFF) / 4; u += NTHR) ((LAS unsigned*)(F.lds + LDSCTL_OFF))[u] = 0u;
    __syncthreads();
    const int lo = args.ph_lo, hi = args.ph_hi;
    XcdBarrier bar; bar.bar = (unsigned*)(ws + WS_CTL) + CW_BAR + args.li * XCD_BAR_WORDS; bar.x = 0; bar.st = nullptr; bar.w = F.wave;
    if (hi - lo > 1) bar = xcd_barrier_post((unsigned*)(ws + WS_CTL) + CW_BAR + args.li * XCD_BAR_WORDS, (volatile LAS unsigned*)(F.lds + MISC_OFF) + 8, F.wave);
#define IN(k) (lo <= (k) && (k) < hi && ((F.lane = fresh_lane()), (F.tid = F.wave * 64 + F.lane), true))
#ifdef TPROBE
    long long tp_a = 0; if (TPROBE == 0) tp_a = wall_clock64();
#define SEAM(k) do { if (IN(k) && IN((k) + 1)) xcd_barrier(bar); if ((k) == TPROBE - 1) tp_a = wall_clock64(); \
        if ((k) == TPROBE && cblk == 0 && F.tid == 0) { const float us = (float)(wall_clock64() - tp_a) * 0.01f; __hip_atomic_store((float*)(ws + WS_CTL) + 262000, 0.05f + us * 0.001f, __ATOMIC_RELAXED, __HIP_MEMORY_SCOPE_AGENT); } } while (0)
#else
#define SEAM(k) do { if (IN(k) && IN((k) + 1)) xcd_barrier(bar); } while (0)
#endif
    LAS unsigned char* ring = F.lds + RING_OFF;
    const int cblk = (int)blockIdx.x;

    if (IN(0)) { p0_prologue(args, F); SEAM(0); }

    if (IN(1)) {
        pg8::Gemm g{(const bf16*)(ws + WS_XN), (const bf16*)(ws + WS_WIN), MT, INCP, DM, 1 << 20, 0}; g.wid = F.wave; pg8::StaticOrder S; S.init(MT, INCP, F.G, cblk);
        pg8::EpiBf16Plain E{(bf16*)(ws + WS_U), INCP};
        const int nconv = (NE * 2048 + F.G * NWAVES - 1) / (F.G * NWAVES), asplit = cblk & 7;
        S.iN = asplit; pg8::gemm_phase<pg8::EpiBf16Plain, pg8::StaticOrder, true, true>(ring, g, S, E);
        conv_stream<0>(args, F, 0, nconv); __syncthreads();
        S.i0 = asplit; S.iN = 1 << 20; pg8::gemm_phase<pg8::EpiBf16Plain, pg8::StaticOrder, true, true>(ring, g, S, E);
        SEAM(1);
    }
    if (IN(2)) {
        p2_attn_prep(args, F);
        for (int u = F.vcu; u < 2 * NB * 8; u += F.G) p3_scan_unit_chunked(args, F, u);
        SEAM(2);
    }
    if (IN(3)) {
        float lam;
        { const float p1 = (F.lane < 64) ? args.in[I_LQ1][F.lane] * args.in[I_LK1][F.lane] : 0.f, p2 = args.in[I_LQ2][F.lane] * args.in[I_LK2][F.lane];
          lam = __expf(wave_sum(p1)) - __expf(wave_sum(p2)) + 0.2f; }
        for (int u = F.vcu; u < NB * 4 * 16; u += F.G) p3_attn_unit(args, F, u, lam);
        for (int u = F.vcu; u < MT / 32; u += F.G) p4_unit(args, F, u);
        SEAM(3);
    }
    if (IN(4)) {
        { pg8::Gemm g{(const bf16*)(ws + WS_MIX), (const bf16*)(ws + WS_WOUT), MT, DM, DM, 1 << 20, 0}; g.wid = F.wave; pg8::StaticOrder S; S.init(MT, DM, F.G, cblk);
          pg8::EpiResBf16 E{args.in[I_X], (bf16*)(ws + WS_HB), DM};
          pg8::gemm_phase<pg8::EpiResBf16, pg8::StaticOrder, true, true>(ring, g, S, E); }
        { pg8::Gemm g{(const bf16*)(ws + WS_PB), (const bf16*)(ws + WS_WPLE), MT, DM, 256, 1 << 20, 0}; g.wid = F.wave; pg8::StaticOrder S; S.init(MT, DM, F.G, cblk);
          pg8::EpiBf16Plain E{(bf16*)(ws + WS_PE), DM};
          pg8::gemm_phase<pg8::EpiBf16Plain, pg8::StaticOrder, true, true>(ring, g, S, E); }
        SEAM(4);
    }
    if (IN(5)) { p6_router(args, F); SEAM(5); }
    if (IN(6)) { for (int u = F.vcu; u < NB * NE; u += F.G) p7_topk_unit(args, F, u); SEAM(6); }
#define MOE_G1(gi) { pg8::Gemm g{(const bf16*)(ws + WS_HN8), (const bf16*)(ws + WS_W13 + (size_t)(gi) * EPG * 4096 * DM), MG, 4096, DM / 2, NB, (size_t)4096 * DM, (const int*)(ws + WS_RMAP) + (size_t)(gi) * MG, TAB_OFF, WSCALE_E8M0}; \
        g.wid = F.wave; pg8::StaticOrder S; S.init(MG, 4096, F.G, cblk); pg8::EpiSwiGLU8 E{ws + WS_HDN + (size_t)(gi) * MG * DFF, DFF}; \
        pg8::gemm_phase<pg8::EpiSwiGLU8, pg8::StaticOrder, true, true, true, true>(ring, g, S, E); }
#define MOE_G2(gi) { pg8::Gemm g{(const bf16*)(ws + WS_HDN + (size_t)(gi) * MG * DFF), (const bf16*)(ws + WS_W2T + (size_t)(gi) * EPG * DM * DFF), MG, DM, DFF / 2, NB, (size_t)DM * DFF, nullptr, 0, WSCALE_E8M0}; \
        g.wid = F.wave; pg8::StaticOrder S; S.init(MG, DM, F.G, cblk); pg8::EpiRowScaleBf16 E{(bf16*)(ws + WS_YE) + (size_t)(gi) * MG * DM, DM, (const float*)(ws + WS_GATE) + (size_t)(gi) * MG}; \
        pg8::gemm_phase<pg8::EpiRowScaleBf16, pg8::StaticOrder, true, true, false, true>(ring, g, S, E); }
    if (IN(7)) {
        const int cpos = (cblk & 7) % 3;
        if (cpos == 0) { conv_stream<1>(args, F, 0, 1 << 20); __syncthreads(); }
        MOE_G1(0)
        if (cpos == 1) { conv_stream<1>(args, F, 0, 1 << 20); __syncthreads(); }
        MOE_G1(1)
        if (cpos == 2) conv_stream<1>(args, F, 0, 1 << 20);
        SEAM(7); }
    if (IN(8)) { MOE_G2(0) MOE_G2(1) SEAM(8); }
#undef MOE_G1
#undef MOE_G2
    if (IN(9)) { moe_combine(args, F); SEAM(9); }
    if (IN(10)) {
        pg8::Gemm g{(const bf16*)(ws + WS_HN2), (const bf16*)(ws + WS_WPG), MT, DM, DM / 2, 1 << 20, 0, nullptr, 0, WSCALE_E8M0}; g.wid = F.wave; pg8::StaticOrder S; S.init(MT, DM, F.G, cblk);
        pg8::EpiPleFinal E{(const bf16*)(ws + WS_H2B), args.out, DM, (const bf16*)(ws + WS_PE), (const float*)(ws + WS_PERS), args.in[I_GPOST]};
#ifdef TPROBE
        E.dbg = 1.0f + __hip_atomic_load((float*)(ws + WS_CTL) + 262000, __ATOMIC_RELAXED, __HIP_MEMORY_SCOPE_AGENT);
#endif
        pg8::gemm_phase<pg8::EpiPleFinal, pg8::StaticOrder, true, true, false, true>(ring, g, S, E);
    }
#undef IN
#undef SEAM
}

#ifndef MK_PER_PHASE
#define MK_PER_PHASE 0
#endif
extern "C" void kernel_launch(void* const* d_in, const int* in_sizes, int n_in, void* d_out, int out_size, void* d_ws, size_t ws_size, hipStream_t stream) {
    static int grid = 0;
    if (grid == 0) {
        if (n_in != N_IN || in_sizes[0] != MT * DM || out_size != MT * DM || ws_size < WS_END) { fprintf(stderr, "kernel_launch: unexpected problem (n_in %d, in0 %d, out %d, ws %zu < %zu): nothing launched\n", n_in, n_in > 0 ? in_sizes[0] : -1, out_size, ws_size, (size_t)WS_END); grid = -1; return; }
        int dev = 0, cus = 0, per_cu = 0;
        if (hipGetDevice(&dev) != hipSuccess || hipDeviceGetAttribute(&cus, hipDeviceAttributeMultiprocessorCount, dev) != hipSuccess) { grid = -1; return; }
        if (hipFuncSetAttribute((const void*)fwd_kernel, hipFuncAttributeMaxDynamicSharedMemorySize, LDS_BYTES) != hipSuccess) { fprintf(stderr, "kernel_launch: hipFuncSetAttribute failed\n"); grid = -1; return; }
        if (hipOccupancyMaxActiveBlocksPerMultiprocessor(&per_cu, (const void*)fwd_kernel, NTHR, LDS_BYTES) != hipSuccess || per_cu < 1) { fprintf(stderr, "kernel_launch: occupancy query says %d blocks per CU\n", per_cu); }
        (void)hipGetLastError();
        grid = cus;
    }
    if (grid < 0) return;
    if (hipMemsetAsync((char*)d_ws + WS_CTL, 0, CTL_ZERO_BYTES, stream) != hipSuccess) return;
    Args a{};
    for (int i = 0; i < N_IN; ++i) a.in[i] = (const float*)d_in[i];
    a.out = (float*)d_out; a.ws = (unsigned char*)d_ws; a.pad = 0;
#if MK_PER_PHASE
#ifndef MK_DUP_PHASE
#define MK_DUP_PHASE -1
#define MK_DUP_N 0
#endif
    for (int p = 0; p <= NPHASE; ++p) for (int rep = 0; rep < 1 + (p == MK_DUP_PHASE ? MK_DUP_N : 0); ++rep) { a.ph_lo = p; a.ph_hi = p + 1; a.li = 0; hipLaunchKernelGGL(fwd_kernel, dim3(grid), dim3(NTHR), LDS_BYTES, stream, a); }
#else
    a.ph_lo = 0; a.ph_hi = NPHASE + 1; a.li = 0;
    hipLaunchKernelGGL(fwd_kernel, dim3(grid), dim3(NTHR), LDS_BYTES, stream, a);
#endif
}
```
